# Optimizing an MI355X kernel written in HIP

```python
import jax, jax.numpy as jnp
from jax import lax
import numpy as np

D_MODEL = 1024
BATCH = 16
SEQ = 256
DEPTH = 2
DEC_BATCH = 2
DEC_SEQ = 4096
PAST_LEN = 512

GRID_W = 64
N_MIXERS = 2
N_ATTN_LAYERS = (DEPTH + 1) // 2
N_DELTA_LAYERS = DEPTH // 2
HEAD_DIM = 128
N_HEADS = 8
N_KV_HEADS = 2
KV_GROUPS = N_HEADS // N_KV_HEADS
ROPE_HALF = HEAD_DIM // 2
ROPE_THETA = 10000.0
Q_BLOCK = 128
DN_HEADS = 8
DN_DK = 128
DN_DV = 128
DN_KEY_W = DN_HEADS * DN_DK
DN_VAL_W = DN_HEADS * DN_DV
DN_QKV_W = 2 * DN_KEY_W + DN_VAL_W
DN_CONV = 3
DN_CHUNK = 64
D_FF = 2816
N_MOD = 9
EPS = 1e-6

kernel_name = "hybrid_diffusion_prefix_step"

F32 = jnp.float32


def rmsnorm(x, g):
    xf = x.astype(F32)
    y = xf * lax.rsqrt(jnp.mean(xf * xf, axis=-1, keepdims=True) + EPS)
    return (y * g.astype(F32)).astype(x.dtype)


def l2norm(x):
    xf = x.astype(F32)
    return xf * lax.rsqrt(jnp.sum(xf * xf, axis=-1, keepdims=True) + EPS)


def modulation(cond, w, b):
    m = jax.nn.silu(cond) @ w + b
    return jnp.split(m, N_MOD, axis=-1)


def modulate(h, gain, shift, scale):
    return rmsnorm(h, gain) * (1 + scale) + shift


def swiglu(x, w_in, w_out):
    a, b = jnp.split(x @ w_in, 2, axis=-1)
    return (jax.nn.silu(a) * b) @ w_out


def axial_rope_tables(n_tokens):
    rows = n_tokens // GRID_W
    row = jnp.repeat(jnp.arange(rows), GRID_W).astype(F32)
    col = jnp.tile(jnp.arange(GRID_W), rows).astype(F32)
    n_freq = ROPE_HALF // 2
    inv = ROPE_THETA ** (-jnp.arange(n_freq, dtype=F32) / n_freq)
    ang = jnp.concatenate([row[:, None] * inv, col[:, None] * inv], axis=-1)
    return jnp.cos(ang), jnp.sin(ang)


def apply_axial_rope(x, cos, sin):
    B, T, H, D = x.shape
    n_freq = ROPE_HALF // 2
    xr = x.astype(F32).reshape(B, T, H, 2, 2, n_freq)
    x1, x2 = xr[..., 0, :], xr[..., 1, :]
    c = cos.reshape(1, T, 1, 2, n_freq)
    s = sin.reshape(1, T, 1, 2, n_freq)
    out = jnp.stack([x1 * c - x2 * s, x2 * c + x1 * s], axis=-2)
    return out.reshape(B, T, H, D).astype(x.dtype)


def attn_project(x, w_qkv, q_gain, k_gain):
    B, T, _ = x.shape
    qkv = x @ w_qkv
    nq, nk = N_HEADS * HEAD_DIM, N_KV_HEADS * HEAD_DIM
    q = qkv[..., :nq].reshape(B, T, N_HEADS, HEAD_DIM)
    k = qkv[..., nq:nq + nk].reshape(B, T, N_KV_HEADS, HEAD_DIM)
    v = qkv[..., nq + nk:].reshape(B, T, N_KV_HEADS, HEAD_DIM)
    return rmsnorm(q, q_gain), rmsnorm(k, k_gain), v


def block_attention(q, k, v):
    B, T = q.shape[:2]
    nb = T // Q_BLOCK
    qb = q.reshape(B, nb, Q_BLOCK, N_KV_HEADS, KV_GROUPS, HEAD_DIM).swapaxes(0, 1)
    scale = HEAD_DIM ** -0.5

    def one_block(qi):
        s = jnp.einsum('bqkgd,bskd->bkgqs', qi, k).astype(F32) * scale
        p = jax.nn.softmax(s, axis=-1).astype(v.dtype)
        return jnp.einsum('bkgqs,bskd->bqkgd', p, v)

    o = lax.map(one_block, qb)
    return o.swapaxes(0, 1).reshape(B, T, N_HEADS * HEAD_DIM)


def attn_context(x, w_qkv, q_gain, k_gain, w_o):
    q, k, v = attn_project(x, w_qkv, q_gain, k_gain)
    return block_attention(q, k, v) @ w_o, k, v


def attn_latent(x, ck, cv, w_qkv, q_gain, k_gain, w_o):
    q, k, v = attn_project(x, w_qkv, q_gain, k_gain)
    cos, sin = axial_rope_tables(x.shape[1])
    q = apply_axial_rope(q, cos, sin)
    k = apply_axial_rope(k, cos, sin)
    keys = jnp.concatenate([ck.astype(k.dtype), k], axis=1)
    vals = jnp.concatenate([cv.astype(v.dtype), v], axis=1)
    return block_attention(q, keys, vals) @ w_o


def centred_conv(x, w):
    T = x.shape[1]
    pad = DN_CONV // 2
    xp = jnp.pad(x, ((0, 0), (pad, pad), (0, 0)))
    out = xp[:, 0:T] * w[0]
    for j in range(1, DN_CONV):
        out = out + xp[:, j:j + T] * w[j]
    return out


def gated_delta_chunked(q, k, v, g, beta, s0):
    B, T, H, DK = q.shape
    DV = v.shape[-1]
    C = DN_CHUNK
    n = T // C

    def to_chunks(t):
        t = t.reshape((B, n, C, H) + t.shape[3:])
        return jnp.moveaxis(t, 3, 1)

    q = to_chunks(q) * (DK ** -0.5)
    k = to_chunks(k)
    v = to_chunks(v)
    gc = jnp.cumsum(to_chunks(g), axis=-1)
    beta = to_chunks(beta)
    idx = jnp.arange(C)
    causal = idx[:, None] >= idx[None, :]
    strict = idx[:, None] > idx[None, :]
    diff = gc[..., :, None] - gc[..., None, :]
    decay = jnp.where(causal, jnp.exp(jnp.where(causal, diff, 0.0)), 0.0)
    kb = k * beta[..., None]
    a = jnp.where(strict, jnp.einsum('bhncd,bhnsd->bhncs', kb, k) * decay, 0.0)
    eye = jnp.eye(C, dtype=F32)
    t_inv = lax.linalg.triangular_solve(a + eye, jnp.broadcast_to(eye, a.shape),
                                        left_side=True, lower=True, unit_diagonal=True)
    u = jnp.einsum('bhncs,bhnsv->bhncv', t_inv, v * beta[..., None])
    w = jnp.einsum('bhncs,bhnsd->bhncd', t_inv, kb * jnp.exp(gc)[..., None])
    qk = jnp.einsum('bhncd,bhnsd->bhncs', q, k) * decay
    q_dec = q * jnp.exp(gc)[..., None]
    k_dec = k * jnp.exp(gc[..., -1:] - gc)[..., None]
    g_last = jnp.exp(gc[..., -1])

    def step(S, xs):
        qk_i, qd_i, w_i, u_i, kd_i, gl_i = xs
        v_new = u_i - jnp.einsum('bhcd,bhdv->bhcv', w_i, S)
        o_i = jnp.einsum('bhcd,bhdv->bhcv', qd_i, S) + jnp.einsum('bhcs,bhsv->bhcv', qk_i, v_new)
        S = S * gl_i[..., None, None] + jnp.einsum('bhcd,bhcv->bhdv', kd_i, v_new)
        return S, o_i

    xs = tuple(jnp.moveaxis(t, 2, 0) for t in (qk, q_dec, w, u, k_dec, g_last))
    s_final, o = lax.scan(step, s0.astype(F32), xs)
    o = jnp.transpose(o, (1, 0, 3, 2, 4)).reshape(B, T, H, DV)
    return o, s_final


def delta_core(x, s_f0, s_b0, w_in, conv_w, w_a, dt_bias, a_log, w_b, out_gain, w_o):
    B, T, _ = x.shape
    proj = x @ w_in
    qkv = jax.nn.silu(centred_conv(proj[..., :DN_QKV_W], conv_w))
    z = proj[..., DN_QKV_W:]
    q = l2norm(qkv[..., :DN_KEY_W].reshape(B, T, DN_HEADS, DN_DK))
    k = l2norm(qkv[..., DN_KEY_W:2 * DN_KEY_W].reshape(B, T, DN_HEADS, DN_DK))
    v = qkv[..., 2 * DN_KEY_W:].reshape(B, T, DN_HEADS, DN_DV).astype(F32)
    a = jnp.einsum('btd,edh->ebth', x, w_a).astype(F32) + dt_bias.astype(F32)[:, None, None, :]
    g = -jnp.exp(a_log.astype(F32))[:, None, None, :] * jax.nn.softplus(a)
    beta = jax.nn.sigmoid(jnp.einsum('btd,edh->ebth', x, w_b).astype(F32))
    o_f, s_f = gated_delta_chunked(q, k, v, g[0], beta[0], s_f0)
    flip = lambda t: jnp.flip(t, axis=1)
    o_b, s_b = gated_delta_chunked(flip(q), flip(k), flip(v), flip(g[1]), flip(beta[1]), s_b0)
    o = rmsnorm(o_f + flip(o_b), out_gain) * jax.nn.silu(z.astype(F32).reshape(B, T, DN_HEADS, DN_DV))
    y = o.reshape(B, T, DN_VAL_W).astype(x.dtype) @ w_o
    return y, s_f, s_b


def setup_inputs(seed: int = 0) -> dict:
    key = jax.random.key(seed)
    ks = iter(jax.random.split(key, 40))

    def nrm(shape, scale):
        return jax.random.normal(next(ks), shape, F32) * scale

    def gain(shape):
        return 1.0 + nrm(shape, 0.05)

    d = D_MODEL
    dt = jnp.exp(jax.random.uniform(next(ks), (N_DELTA_LAYERS, 2, DN_HEADS), F32,
                                    minval=float(np.log(1e-3)), maxval=float(np.log(1e-1))))
    dt_bias = dt + jnp.log(-jnp.expm1(-dt))
    a_log = jnp.log(jax.random.uniform(next(ks), (N_DELTA_LAYERS, 2, DN_HEADS), F32, minval=1.0, maxval=16.0))
    return {
        "x_prompt": nrm((BATCH, SEQ, d), 1.0),
        "x_sample": nrm((DEC_BATCH, DEC_SEQ, d), 1.0),
        "cache_k": nrm((DEC_BATCH, N_ATTN_LAYERS, PAST_LEN, N_KV_HEADS, HEAD_DIM), 1.0),
        "cache_v": nrm((DEC_BATCH, N_ATTN_LAYERS, PAST_LEN, N_KV_HEADS, HEAD_DIM), 1.0),
        "state_fwd": nrm((DEC_BATCH, N_DELTA_LAYERS, DN_HEADS, DN_DK, DN_DV), 0.1),
        "state_bwd": nrm((DEC_BATCH, N_DELTA_LAYERS, DN_HEADS, DN_DK, DN_DV), 0.1),
        "c": nrm((DEC_BATCH, d), 1.0),
        "c_ctx": nrm((d,), 1.0),
        "ada_w": nrm((DEPTH, d, N_MOD * d), 0.5 * d ** -0.5),
        "ada_b": nrm((DEPTH, N_MOD * d), 0.02),
        "norm_ffn1": gain((DEPTH, d)),
        "ffn1_w_in": nrm((DEPTH, d, 2 * D_FF), d ** -0.5),
        "ffn1_w_out": nrm((DEPTH, D_FF, d), D_FF ** -0.5),
        "norm_mix": gain((DEPTH, d)),
        "attn_w_qkv": nrm((N_ATTN_LAYERS, d, (N_HEADS + 2 * N_KV_HEADS) * HEAD_DIM), d ** -0.5),
        "attn_q_norm": gain((N_ATTN_LAYERS, HEAD_DIM)),
        "attn_k_norm": gain((N_ATTN_LAYERS, HEAD_DIM)),
        "attn_w_o": nrm((N_ATTN_LAYERS, N_HEADS * HEAD_DIM, d), (N_HEADS * HEAD_DIM) ** -0.5),
        "dn_w_in": nrm((N_DELTA_LAYERS, d, DN_QKV_W + DN_VAL_W), d ** -0.5),
        "dn_conv": nrm((N_DELTA_LAYERS, DN_CONV, DN_QKV_W), DN_CONV ** -0.5),
        "dn_w_a": nrm((N_DELTA_LAYERS, 2, d, DN_HEADS), 0.1 * d ** -0.5),
        "dn_dt_bias": dt_bias,
        "dn_a_log": a_log,
        "dn_w_b": nrm((N_DELTA_LAYERS, 2, d, DN_HEADS), d ** -0.5),
        "dn_out_norm": gain((N_DELTA_LAYERS, DN_DV)),
        "dn_w_o": nrm((N_DELTA_LAYERS, DN_VAL_W, d), DN_VAL_W ** -0.5),
        "norm_ffn2": gain((DEPTH, d)),
        "ffn2_w_in": nrm((DEPTH, d, 2 * D_FF), d ** -0.5),
        "ffn2_w_out": nrm((DEPTH, D_FF, d), D_FF ** -0.5),
        "final_norm": gain((d,)),
    }


def reference(x_prompt, x_sample, cache_k, cache_v, state_fwd, state_bwd, c, c_ctx,
              ada_w, ada_b, norm_ffn1, ffn1_w_in, ffn1_w_out, norm_mix,
              attn_w_qkv, attn_q_norm, attn_k_norm, attn_w_o,
              dn_w_in, dn_conv, dn_w_a, dn_dt_bias, dn_a_log, dn_w_b, dn_out_norm, dn_w_o,
              norm_ffn2, ffn2_w_in, ffn2_w_out, final_norm):
    ctx_cond = c_ctx[None, None, :]
    lat_cond = c[:, None, :]
    hp, hs = x_prompt, x_sample
    new_k, new_v, new_sf, new_sb = [], [], [], []
    for i in range(DEPTH):
        mp = modulation(ctx_cond, ada_w[i], ada_b[i])
        ms = modulation(lat_cond, ada_w[i], ada_b[i])
        hp = hp + 0.5 * mp[2] * swiglu(modulate(hp, norm_ffn1[i], mp[0], mp[1]), ffn1_w_in[i], ffn1_w_out[i])
        hs = hs + 0.5 * ms[2] * swiglu(modulate(hs, norm_ffn1[i], ms[0], ms[1]), ffn1_w_in[i], ffn1_w_out[i])
        up = modulate(hp, norm_mix[i], mp[3], mp[4])
        us = modulate(hs, norm_mix[i], ms[3], ms[4])
        j = i // N_MIXERS
        if i % N_MIXERS == 0:
            yp, kc, vc = attn_context(up, attn_w_qkv[j], attn_q_norm[j], attn_k_norm[j], attn_w_o[j])
            ys = attn_latent(us, cache_k[:, j], cache_v[:, j], attn_w_qkv[j], attn_q_norm[j],
                             attn_k_norm[j], attn_w_o[j])
            new_k.append(kc)
            new_v.append(vc)
        else:
            zero_state = jnp.zeros((hp.shape[0], DN_HEADS, DN_DK, DN_DV), F32)
            yp, sf, sb = delta_core(up, zero_state, zero_state, dn_w_in[j], dn_conv[j], dn_w_a[j],
                                    dn_dt_bias[j], dn_a_log[j], dn_w_b[j], dn_out_norm[j], dn_w_o[j])
            ys, _, _ = delta_core(us, state_fwd[:, j], state_bwd[:, j], dn_w_in[j], dn_conv[j], dn_w_a[j],
                                  dn_dt_bias[j], dn_a_log[j], dn_w_b[j], dn_out_norm[j], dn_w_o[j])
            new_sf.append(sf.astype(x_prompt.dtype))
            new_sb.append(sb.astype(x_prompt.dtype))
        hp = hp + mp[5] * yp
        hs = hs + ms[5] * ys
        hp = hp + 0.5 * mp[8] * swiglu(modulate(hp, norm_ffn2[i], mp[6], mp[7]), ffn2_w_in[i], ffn2_w_out[i])
        hs = hs + 0.5 * ms[8] * swiglu(modulate(hs, norm_ffn2[i], ms[6], ms[7]), ffn2_w_in[i], ffn2_w_out[i])
    y_prompt = rmsnorm(hp, final_norm)
    y_sample = rmsnorm(hs, final_norm)
    return (y_prompt, y_sample, jnp.stack(new_k, axis=1), jnp.stack(new_v, axis=1),
            jnp.stack(new_sf, axis=1), jnp.stack(new_sb, axis=1))
```

```cpp
#include <hip/hip_runtime.h>
#include <hip/hip_bf16.h>
#include <hip/hip_cooperative_groups.h>
#include <cstdio>
#include <cstdint>
namespace cg = cooperative_groups;
#ifndef REP_D2
#define REP_D2 0
#endif
#ifndef REP_ATT
#define REP_ATT 0
#endif
#ifndef REP_D1
#define REP_D1 0
#endif
#ifndef REP_G1
#define REP_G1 0
#endif
#ifndef REP_P0
#define REP_P0 0
#endif
#ifndef REP_NM
#define REP_NM 0
#endif
typedef __bf16 bf16x2_t __attribute__((ext_vector_type(2)));
typedef float f32x2_t __attribute__((ext_vector_type(2)));
__device__ __forceinline__ unsigned cvtpk_rne(float lo, float hi) { f32x2_t v = {lo, hi}; bf16x2_t b = __builtin_convertvector(v, bf16x2_t); return __builtin_bit_cast(unsigned, b); }
__device__ __forceinline__ int ltid(int wv) { int l; asm volatile("v_mbcnt_lo_u32_b32 %0, -1, 0\n\tv_mbcnt_hi_u32_b32 %0, -1, %0" : "=v"(l)); return (wv << 6) | l; }

namespace pg8 {
#define PG8_LAS __attribute__((address_space(3)))
typedef unsigned short bf16_t;
typedef short bf16x8 __attribute__((ext_vector_type(8)));
typedef float f32x4 __attribute__((ext_vector_type(4)));
typedef unsigned u32x4 __attribute__((ext_vector_type(4)));
constexpr int BM = 256, BK = 64, HALF = 128, HTB = HALF * BK * 2  , STAGE_BYTES = 8 * HTB, NXCD = 8, WGM = 8;

__host__ __device__ __forceinline__ int lds_byte(int r, int c) { const int st = (r >> 4) * 2 + (c >> 5), rr = r & 15, cc = c & 31, ob = rr * 64 + cc * 2; return st * 1024 + (ob ^ (((ob >> 9) & 1) << 5)); }
__host__ __device__ __forceinline__ void stage_rc(int b, int& R, int& C) { const int st = b / 1024, sb = b % 1024, swz = sb ^ (((sb >> 9) & 1) << 5); R = (st >> 1) * 16 + swz / 64; C = (st & 1) * 32 + (swz % 64) / 2; }
__host__ __device__ __forceinline__ int perm32(int rho) { const int n = rho >> 4, i = rho & 15; return 8 * (i >> 2) + 4 * n + (i & 3); }

struct Unit { int pm, pn; };
struct Gemm { const bf16_t* A; const bf16_t* Bt; int M, N, K; };

struct StaticOrder {
    int nM, nN, nwg, G, c;
    __host__ __device__ void init(int M, int N, int G_, int c_) { nM = M / BM; nN = N / BM; nwg = nM * nN; G = G_; c = c_; }
    __host__ __device__ bool next(int i, Unit& u) const {
        const long L = (long)i * G + c; if (L >= nwg) return false;
        int wgid = (int)L; { const int q = nwg / NXCD, r = nwg % NXCD, xcd = wgid % NXCD, off = wgid / NXCD; wgid = (xcd < r ? xcd * (q + 1) : r * (q + 1) + (xcd - r) * q) + off; }
        const int nig = WGM * nN, gid = wgid / nig, fm = gid * WGM, gsz = (nM - fm) < WGM ? (nM - fm) : WGM;
        u.pm = fm + ((wgid % nig) % gsz); u.pn = (wgid % nig) / gsz; return true;
    }
    __device__ __forceinline__ void a_ready(const Unit&) const {}
    __device__ __forceinline__ void done(const Unit&) const {}
};

__device__ __forceinline__ unsigned cvt_pk_bf16(float lo, float hi) { return cvtpk_rne(lo, hi); }
typedef unsigned u32x2 __attribute__((ext_vector_type(2)));
__device__ __forceinline__ float silu_f(float x) { return x * __builtin_amdgcn_rcpf(1.0f + __expf(-x)); }

struct EpiSwiglu {
    static constexpr bool PERM = true, AFTER_DRAIN = false;
    bf16_t* G; int ldg;
    __device__ __forceinline__ void operator()(const f32x4 (&acc)[2][2][4][2], const Unit& u, int wr, int wc, int fr, int fq) const {
        asm volatile("" : "+v"(fr), "+v"(fq));
        const int row0 = u.pm * BM + wr * 64 + fr, col0 = u.pn * HALF + wc * 32 + 8 * fq;
#pragma unroll
        for (int ai = 0; ai < 2; ++ai)
#pragma unroll
            for (int m = 0; m < 4; ++m) {
                bf16_t* rowp = G + (size_t)(row0 + ai * HALF + m * 16) * ldg + col0;
                const f32x4 a0 = acc[ai][0][m][0], a1 = acc[ai][0][m][1], b0 = acc[ai][1][m][0], b1 = acc[ai][1][m][1];
                f32x4 v0, v1;
#pragma unroll
                for (int j = 0; j < 4; ++j) { v0[j] = silu_f(a0[j]) * b0[j]; v1[j] = silu_f(a1[j]) * b1[j]; }
                u32x4 w; w.x = cvt_pk_bf16(v0[0], v0[1]); w.y = cvt_pk_bf16(v0[2], v0[3]); w.z = cvt_pk_bf16(v1[0], v1[1]); w.w = cvt_pk_bf16(v1[2], v1[3]);
                *(u32x4*)rowp = w;
            }
    }
};
struct EpiResid {
    static constexpr bool PERM = false, AFTER_DRAIN = false;
    float* h; const float* gate; float coef;
    __device__ __forceinline__ void operator()(const f32x4 (&acc)[2][2][4][2], const Unit& u, int wr, int wc, int fr, int fq) const {
        asm volatile("" : "+v"(fr), "+v"(fq));
        const int cond = u.pm < 16 ? 0 : (u.pm < 32 ? 1 : 2);
        const int row0 = u.pm * BM + wr * 64 + fr, col0 = u.pn * BM + wc * 32 + 4 * fq;
        const float* g = gate + cond * 9216 + col0;
        f32x4 gv[2][2];
#pragma unroll
        for (int bj = 0; bj < 2; ++bj)
#pragma unroll
            for (int n = 0; n < 2; ++n) gv[bj][n] = *(const f32x4*)(g + bj * HALF + n * 16) * coef;
#pragma unroll
        for (int ai = 0; ai < 2; ++ai)
#pragma unroll
            for (int m = 0; m < 4; ++m) { float* rowp = h + (size_t)(row0 + ai * HALF + m * 16) * 1024 + col0;
#pragma unroll
                for (int bj = 0; bj < 2; ++bj)
#pragma unroll
                    for (int n = 0; n < 2; ++n) { float* p = rowp + bj * HALF + n * 16; *(f32x4*)p = *(const f32x4*)p + gv[bj][n] * acc[ai][bj][m][n]; } }
    }
};

struct EpiResidNorm {
    static constexpr bool PERM = false, AFTER_DRAIN = true;
    float* h; const float* gate; const float* ngain; const float* nmod; bf16_t* XN; float* xbuf; unsigned* cnt; float coef; int ishift, iscale, pad_;
    __device__ __forceinline__ void operator()(const f32x4 (&)[2][2][4][2], const Unit&, int, int, int, int) const {}
    __device__ __forceinline__ void fused(f32x4 (&acc)[2][2][4][2], const Unit& u, int wr, int wc, int fr, int fq, PG8_LAS unsigned char* lds, int wid, int lane) const {
        float* const h_ = h; const float* const gate_ = gate; const float coef_ = coef; const float* const ngain_ = ngain; const float* const nmod_ = nmod; const int ishift_ = ishift, iscale_ = iscale; bf16_t* const XN_ = XN; float* const xbuf_ = xbuf; unsigned* const cnt_ = cnt;
        asm volatile("" : "+v"(fr), "+v"(fq));
        const int cond = u.pm < 16 ? 0 : (u.pm < 32 ? 1 : 2);
        const int row0 = u.pm * BM + wr * 64 + fr, col0 = u.pn * BM + wc * 32 + 4 * fq;
        PG8_LAS float* Pt = (PG8_LAS float*)lds; PG8_LAS float* St = Pt + 1024;
        {   const float* g = gate_ + cond * 9216 + col0;
            f32x4 gv[2][2];
#pragma unroll
            for (int bj = 0; bj < 2; ++bj)
#pragma unroll
                for (int n = 0; n < 2; ++n) gv[bj][n] = *(const f32x4*)(g + bj * HALF + n * 16) * coef_;
#pragma unroll
            for (int ai = 0; ai < 2; ++ai)
#pragma unroll
                for (int m = 0; m < 4; ++m) { float* rowp = h_ + (size_t)(row0 + ai * HALF + m * 16) * 1024 + col0; float s = 0.f;
#pragma unroll
                    for (int bj = 0; bj < 2; ++bj)
#pragma unroll
                        for (int n = 0; n < 2; ++n) { float* p = rowp + bj * HALF + n * 16; const f32x4 hv = *(const f32x4*)p + gv[bj][n] * acc[ai][bj][m][n];
                            acc[ai][bj][m][n] = hv; if (iscale_ >= 0) *(f32x4*)p = hv; s += (hv[0] * hv[0] + hv[1] * hv[1]) + (hv[2] * hv[2] + hv[3] * hv[3]); }
                    s += __shfl_xor(s, 16); s += __shfl_xor(s, 32);
                    if (fq == 0) Pt[(ai * HALF + wr * 64 + m * 16 + fr) * 4 + wc] = s;
                    asm volatile("" ::: "memory"); }
        }
        asm volatile("s_waitcnt lgkmcnt(0)" ::: "memory"); __builtin_amdgcn_s_barrier(); asm volatile("" ::: "memory");
        const int row = wid * 32 + (lane & 31);
        if (lane < 32) { const f32x4 p4 = *(const PG8_LAS f32x4*)(Pt + row * 4);
            __hip_atomic_store(xbuf_ + ((size_t)u.pm * BM + row) * 4 + u.pn, (p4[0] + p4[1]) + (p4[2] + p4[3]), __ATOMIC_RELAXED, __HIP_MEMORY_SCOPE_AGENT); }
        asm volatile("s_waitcnt vmcnt(0)" ::: "memory");
        if (lane == 0) __hip_atomic_fetch_add(cnt_ + 64 * u.pm, 1u, __ATOMIC_RELAXED, __HIP_MEMORY_SCOPE_AGENT);
        if (wid == 0) { unsigned sp = 0;
            while ((unsigned)__builtin_amdgcn_readfirstlane(__hip_atomic_load(cnt_ + 64 * u.pm, __ATOMIC_RELAXED, __HIP_MEMORY_SCOPE_AGENT)) < 32u) { __builtin_amdgcn_s_sleep(2); if (++sp > (1u << 22)) break; }
            __builtin_amdgcn_fence(__ATOMIC_ACQUIRE, "agent"); }
        asm volatile("s_waitcnt vmcnt(0) lgkmcnt(0)" ::: "memory"); __builtin_amdgcn_s_barrier(); asm volatile("" ::: "memory");
        if (lane < 32) { const float* sl = xbuf_ + ((size_t)u.pm * BM + row) * 4; float t = 0.f;
#pragma unroll
            for (int k = 0; k < 4; ++k) t += __hip_atomic_load(sl + k, __ATOMIC_RELAXED, __HIP_MEMORY_SCOPE_AGENT);
            St[row] = 1.0f / sqrtf(t * (1.0f / 1024.0f) + 1e-6f); }
        asm volatile("s_waitcnt vmcnt(0) lgkmcnt(0)" ::: "memory"); __builtin_amdgcn_s_barrier(); asm volatile("" ::: "memory");
        const float* gp = ngain_ + col0; const float* shp = nmod_ + cond * 9216 + (iscale_ >= 0 ? ishift_ : 0) * 1024 + col0; const float* scp = nmod_ + cond * 9216 + (iscale_ >= 0 ? iscale_ : 0) * 1024 + col0;
#pragma unroll
        for (int ai = 0; ai < 2; ++ai)
#pragma unroll
            for (int m = 0; m < 4; ++m) { const int r = ai * HALF + wr * 64 + m * 16 + fr; const float rinv = St[r]; const size_t off = (size_t)(u.pm * BM + r) * 1024 + col0;
#pragma unroll
                for (int bj = 0; bj < 2; ++bj)
#pragma unroll
                    for (int n = 0; n < 2; ++n) { const int co = bj * HALF + n * 16; const f32x4 gn = *(const f32x4*)(gp + co); f32x4 y = acc[ai][bj][m][n] * rinv * gn;
                        if (iscale_ >= 0) { const f32x4 sv = *(const f32x4*)(shp + co), cv = *(const f32x4*)(scp + co); y = y * (cv + 1.0f) + sv;
                            u32x2 w; w.x = cvt_pk_bf16(y[0], y[1]); w.y = cvt_pk_bf16(y[2], y[3]); *(u32x2*)(XN_ + off + co) = w; }
                        else *(f32x4*)(h_ + off + co) = y; }
                asm volatile("" ::: "memory"); }
    }
};
struct EpiQKV {
    static constexpr bool PERM = false, AFTER_DRAIN = false;
    bf16_t *Q, *KB, *VB; float *outk, *outv; const float *qg, *kg, *rope; PG8_LAS float* red;
    __device__ __forceinline__ void operator()(const f32x4 (&acc)[2][2][4][2], const Unit& u, int wr, int wc, int fr, int fq) const {
        asm volatile("" : "+v"(fr), "+v"(fq));
        const int pn = u.pn;
        if (pn < 5) {
#pragma unroll
            for (int ai = 0; ai < 2; ++ai)
#pragma unroll
                for (int m = 0; m < 4; ++m)
#pragma unroll
                    for (int bj = 0; bj < 2; ++bj) {
                        const f32x4 x = acc[ai][bj][m][0], y = acc[ai][bj][m][1];
                        float s = (x[0] * x[0] + x[1] * x[1]) + (x[2] * x[2] + x[3] * x[3]) + (y[0] * y[0] + y[1] * y[1]) + (y[2] * y[2] + y[3] * y[3]);
                        s += __shfl_xor(s, 16); s += __shfl_xor(s, 32);
                        if (fq == 0) red[((ai * HALF + wr * 64 + m * 16 + fr) * 2 + bj) * 4 + wc] = s;
                    }
            asm volatile("s_waitcnt lgkmcnt(0)" ::: "memory"); __builtin_amdgcn_s_barrier(); asm volatile("" ::: "memory");
            const float* gain = pn < 4 ? qg : kg;
            const int d0 = (wc >> 1) * 64 + (wc & 1) * 16 + fq * 4, f0 = (wc & 1) * 16 + fq * 4;
            const f32x4 g1 = *(const f32x4*)(gain + d0), g2 = *(const f32x4*)(gain + d0 + 32);
#pragma unroll
            for (int ai = 0; ai < 2; ++ai)
#pragma unroll
                for (int m = 0; m < 4; ++m) {
                    const int rl = ai * HALF + wr * 64 + m * 16 + fr, row = u.pm * BM + rl;
                    f32x4 cs = {1.f, 1.f, 1.f, 1.f}, sn = {0.f, 0.f, 0.f, 0.f};
                    if (u.pm >= 16) { const int t = (row - 4096) & 4095, pos = (wc >> 1) ? (t & 63) : (t >> 6);
                        cs = *(const f32x4*)(rope + pos * 32 + f0); sn = *(const f32x4*)(rope + 2048 + pos * 32 + f0); }
                    const int krow = row < 4096 ? row : 4096 + ((row - 4096) >> 12) * 4608 + 512 + ((row - 4096) & 4095);
#pragma unroll
                    for (int bj = 0; bj < 2; ++bj) {
                        const f32x4 pr = *(const PG8_LAS f32x4*)(red + (rl * 2 + bj) * 4);
                        const float rinv = __builtin_amdgcn_rsqf(((pr[0] + pr[1]) + (pr[2] + pr[3])) * (1.0f / 128.0f) + 1e-6f);
                        const f32x4 x1 = acc[ai][bj][m][0] * rinv * g1, x2 = acc[ai][bj][m][1] * rinv * g2;
                        const f32x4 o1 = x1 * cs - x2 * sn, o2 = x2 * cs + x1 * sn;
                        u32x2 w1, w2; w1.x = cvt_pk_bf16(o1[0], o1[1]); w1.y = cvt_pk_bf16(o1[2], o1[3]); w2.x = cvt_pk_bf16(o2[0], o2[1]); w2.y = cvt_pk_bf16(o2[2], o2[3]);
                        if (pn < 4) { bf16_t* dst = Q + (size_t)row * 1024 + (pn * 2 + bj) * 128 + d0; *(u32x2*)dst = w1; *(u32x2*)(dst + 32) = w2; }
                        else { bf16_t* dst = KB + (size_t)krow * 256 + bj * 128 + d0; *(u32x2*)dst = w1; *(u32x2*)(dst + 32) = w2;
                            if (row < 4096) { float* ok = outk + (size_t)row * 256 + bj * 128 + d0; *(f32x4*)ok = o1; *(f32x4*)(ok + 32) = o2; } }
                    }
                    asm volatile("" ::: "memory");
                }
        } else {
#pragma unroll
            for (int ai = 0; ai < 2; ++ai)
#pragma unroll
                for (int m = 0; m < 4; ++m) {
                    const int row = u.pm * BM + ai * HALF + wr * 64 + m * 16 + fr;
                    const int krow = row < 4096 ? row : 4096 + ((row - 4096) >> 12) * 4608 + 512 + ((row - 4096) & 4095);
#pragma unroll
                    for (int bj = 0; bj < 2; ++bj)
#pragma unroll
                        for (int n = 0; n < 2; ++n) {
                            const int c0 = bj * HALF + wc * 32 + n * 16 + 4 * fq; const f32x4 v = acc[ai][bj][m][n];
                            u32x2 w; w.x = cvt_pk_bf16(v[0], v[1]); w.y = cvt_pk_bf16(v[2], v[3]);
                            *(u32x2*)(VB + (size_t)krow * 256 + c0) = w;
                            if (row < 4096) *(f32x4*)(outv + (size_t)row * 256 + c0) = v;
                        }
                    asm volatile("" ::: "memory");
                }
        }
    }
};
struct EpiDN {
    static constexpr bool PERM = false, AFTER_DRAIN = false;
    bf16_t *QKV, *Z; float* AB;
    __device__ __forceinline__ void operator()(const f32x4 (&acc)[2][2][4][2], const Unit& u, int wr, int wc, int fr, int fq) const {
        asm volatile("" : "+v"(fr), "+v"(fq));
        const int pn = u.pn, row0 = u.pm * BM + wr * 64 + fr;
        if (pn < 16) {
            bf16_t* base = pn < 12 ? QKV : Z; const int ld = pn < 12 ? 3072 : 1024, colb = (pn < 12 ? pn : pn - 12) * BM + wc * 32 + 4 * fq;
#pragma unroll
            for (int ai = 0; ai < 2; ++ai)
#pragma unroll
                for (int m = 0; m < 4; ++m) { bf16_t* rowp = base + (size_t)(row0 + ai * HALF + m * 16) * ld + colb;
#pragma unroll
                    for (int bj = 0; bj < 2; ++bj)
#pragma unroll
                        for (int n = 0; n < 2; ++n) { const f32x4 v = acc[ai][bj][m][n]; u32x2 w; w.x = cvt_pk_bf16(v[0], v[1]); w.y = cvt_pk_bf16(v[2], v[3]); *(u32x2*)(rowp + bj * HALF + n * 16) = w; } }
        } else if (wc == 0) {
#pragma unroll
            for (int ai = 0; ai < 2; ++ai)
#pragma unroll
                for (int m = 0; m < 4; ++m) { float* rowp = AB + (size_t)(row0 + ai * HALF + m * 16) * 32 + 4 * fq;
#pragma unroll
                    for (int n = 0; n < 2; ++n) *(f32x4*)(rowp + n * 16) = acc[ai][0][m][n]; }
        }
    }
};
template <class Epi, class Sched, bool ALIGN_EPI = false, bool SP2 = false>
__device__ __forceinline__ void gemm_phase(PG8_LAS unsigned char* lds, const Gemm g, const Sched& S, const Epi& E, int wv) {
    const int tid = ltid(wv), wid = __builtin_amdgcn_readfirstlane(tid >> 6), lane = tid & 63, wr = wid >> 2, wc = wid & 3, fr = lane & 15, fq = lane >> 4;
    const int K = g.K, nt = K / BK;
    unsigned voffA[2], voffB[2];
#pragma unroll
    for (int i = 0; i < 2; ++i) { int R, C; stage_rc(tid * 16 + i * 8192, R, C); const int Rb = Epi::PERM ? ((R & ~31) + perm32(R & 31)) : R;
        voffA[i] = (unsigned)(R * K + C) * 2u; voffB[i] = (unsigned)(Rb * K + C) * 2u; }
    const size_t kstep = (size_t)(BK * 2);
    const size_t hstep = (size_t)HALF * K * 2;
    const size_t tstep = 2 * hstep;
    const unsigned ldsw = (unsigned)wid * 1024u;
    const int aoff = lds_byte(wr * 64 + fr, fq * 8), boff = lds_byte(wc * 32 + fr, fq * 8);
#define PG8_SA(b, h) (((b) * 2 + (h)) * HTB)
#define PG8_SB(b, h) ((4 + (b) * 2 + (h)) * HTB)
#define PG8_STAGE(bufoff, gbase, voff) do { _Pragma("unroll") for (int _i = 0; _i < 2; ++_i) \
        __builtin_amdgcn_global_load_lds((const unsigned*)((const char*)(gbase) + (voff)[_i]), (PG8_LAS unsigned*)(lds + (bufoff) + ldsw + _i * 8192), 16, 0, 0); } while (0)
#define PG8_LDA(dst, b, h) do { _Pragma("unroll") for (int m = 0; m < 4; ++m) _Pragma("unroll") for (int k = 0; k < 2; ++k) dst[m][k] = *(const PG8_LAS bf16x8*)(lds + PG8_SA(b, h) + aoff + m * 2048 + k * 1024); } while (0)
#define PG8_LDB(dst, b, h) do { _Pragma("unroll") for (int n = 0; n < 2; ++n) _Pragma("unroll") for (int k = 0; k < 2; ++k) dst[n][k] = *(const PG8_LAS bf16x8*)(lds + PG8_SB(b, h) + boff + n * 2048 + k * 1024); } while (0)
#define PG8_MMA(ai, bj, At, Bt) do { __builtin_amdgcn_s_setprio(1); _Pragma("unroll") for (int m = 0; m < 4; ++m) _Pragma("unroll") for (int n = 0; n < 2; ++n) _Pragma("unroll") for (int k = 0; k < 2; ++k) \
        acc[ai][bj][m][n] = __builtin_amdgcn_mfma_f32_16x16x32_bf16(Bt[n][k], At[m][k], acc[ai][bj][m][n], 0, 0, 0); __builtin_amdgcn_s_setprio(0); } while (0)
#define PG8_WAIT_V(n) asm volatile("s_waitcnt vmcnt(" #n ")" ::: "memory")
#define PG8_WAIT_L(n) asm volatile("s_waitcnt lgkmcnt(" #n ")" ::: "memory")
#define PG8_BAR __builtin_amdgcn_s_barrier()
#define PG8_SCHED __builtin_amdgcn_sched_barrier(0)
    Unit cur, nxt; int ui = 0;
    if (!S.next(0, cur)) return;
    f32x4 acc[2][2][4][2];
#pragma unroll
    for (int a = 0; a < 2; ++a)
#pragma unroll
        for (int b = 0; b < 2; ++b)
#pragma unroll
            for (int m = 0; m < 4; ++m)
#pragma unroll
                for (int n = 0; n < 2; ++n) acc[a][b][m][n] = (f32x4){0.f, 0.f, 0.f, 0.f};
    bf16x8 At[4][2], B0[2][2], B1[2][2];
    const char* cA = (const char*)g.A + (size_t)cur.pm * tstep; const char* cB = (const char*)g.Bt + (size_t)cur.pn * tstep;
    S.a_ready(cur);
    if constexpr (SP2) {
        PG8_STAGE(PG8_SB(0, 0), cB, voffB); PG8_STAGE(PG8_SB(0, 1), cB + hstep, voffB); PG8_STAGE(PG8_SA(0, 0), cA, voffA); PG8_STAGE(PG8_SA(0, 1), cA + hstep, voffA);
        if (wr == 1) PG8_BAR;
        PG8_WAIT_V(2); PG8_BAR;
        PG8_STAGE(PG8_SB(1, 0), cB + kstep, voffB); PG8_STAGE(PG8_SA(1, 0), cA + kstep, voffA); PG8_STAGE(PG8_SB(1, 1), cB + hstep + kstep, voffB);
        PG8_WAIT_V(6); PG8_BAR;
    } else {
        PG8_STAGE(PG8_SB(0, 0), cB, voffB); PG8_STAGE(PG8_SA(0, 0), cA, voffA); PG8_STAGE(PG8_SB(0, 1), cB + hstep, voffB); PG8_STAGE(PG8_SA(0, 1), cA + hstep, voffA);
        if (wr == 1) PG8_BAR;
        PG8_WAIT_V(4); PG8_BAR;
        PG8_STAGE(PG8_SB(1, 0), cB + kstep, voffB); PG8_STAGE(PG8_SA(1, 0), cA + kstep, voffA); PG8_STAGE(PG8_SB(1, 1), cB + hstep + kstep, voffB);
        PG8_WAIT_V(6); PG8_BAR;
    }
    for (;;) {
        const bool has_next = S.next(ui + 1, nxt);
        const char* nA = has_next ? (const char*)g.A + (size_t)nxt.pm * tstep : cA; const char* nB = has_next ? (const char*)g.Bt + (size_t)nxt.pn * tstep : cB;
        for (int t = 0; t < nt; t += 2) {
            const bool last = (t == nt - 2);
            const char* a1 = cA + (size_t)(t + 1) * kstep;
            const char* a2 = last ? nA : cA + (size_t)(t + 2) * kstep; const char* b2 = last ? nB : cB + (size_t)(t + 2) * kstep;
            const char* a3 = a2 + kstep; const char* b3 = b2 + kstep;
            if (last && has_next) S.a_ready(nxt);
            if constexpr (SP2) {
            PG8_LDB(B0, 0, 0); PG8_LDB(B1, 0, 1); PG8_SCHED; PG8_LDA(At, 0, 0); PG8_STAGE(PG8_SA(1, 1), a1 + hstep, voffA);
            PG8_WAIT_V(8); PG8_WAIT_L(0); PG8_BAR; PG8_MMA(0, 0, At, B0); PG8_MMA(0, 1, At, B1); PG8_BAR; PG8_SCHED;
            PG8_LDA(At, 0, 1); PG8_STAGE(PG8_SB(0, 0), b2, voffB); PG8_STAGE(PG8_SB(0, 1), b2 + hstep, voffB); PG8_STAGE(PG8_SA(0, 0), a2, voffA);
            PG8_WAIT_V(8); PG8_WAIT_L(0); PG8_BAR; PG8_MMA(1, 0, At, B0); PG8_MMA(1, 1, At, B1); PG8_BAR; PG8_SCHED;
            PG8_LDB(B0, 1, 0); PG8_LDB(B1, 1, 1); PG8_SCHED; PG8_LDA(At, 1, 0); PG8_STAGE(PG8_SA(0, 1), a2 + hstep, voffA);
            PG8_WAIT_V(8); PG8_WAIT_L(0); PG8_BAR; PG8_MMA(0, 0, At, B0); PG8_MMA(0, 1, At, B1); PG8_BAR; PG8_SCHED;
            PG8_LDA(At, 1, 1); PG8_STAGE(PG8_SB(1, 0), b3, voffB); PG8_STAGE(PG8_SB(1, 1), b3 + hstep, voffB); PG8_STAGE(PG8_SA(1, 0), a3, voffA);
            PG8_WAIT_V(8); PG8_WAIT_L(0); PG8_BAR; PG8_MMA(1, 0, At, B0); PG8_MMA(1, 1, At, B1); PG8_BAR; PG8_SCHED;
            } else {
            PG8_LDB(B0, 0, 0); PG8_SCHED; PG8_LDA(At, 0, 0); PG8_STAGE(PG8_SA(1, 1), a1 + hstep, voffA);
            PG8_WAIT_L(8); PG8_BAR; PG8_WAIT_L(0); PG8_MMA(0, 0, At, B0); PG8_BAR; PG8_SCHED;
            PG8_LDB(B1, 0, 1); PG8_STAGE(PG8_SB(0, 0), b2, voffB);
            PG8_BAR; PG8_WAIT_L(0); PG8_MMA(0, 1, At, B1); PG8_BAR;
            PG8_LDA(At, 0, 1); PG8_STAGE(PG8_SA(0, 0), a2, voffA);
            PG8_BAR; PG8_WAIT_L(0); PG8_MMA(1, 0, At, B0); PG8_BAR; PG8_SCHED;
            PG8_STAGE(PG8_SB(0, 1), b2 + hstep, voffB);
            PG8_WAIT_V(6); PG8_BAR; PG8_MMA(1, 1, At, B1); PG8_BAR;
            PG8_LDB(B0, 1, 0); PG8_SCHED; PG8_LDA(At, 1, 0); PG8_STAGE(PG8_SA(0, 1), a2 + hstep, voffA);
            PG8_WAIT_L(8); PG8_BAR; PG8_WAIT_L(0); PG8_MMA(0, 0, At, B0); PG8_BAR; PG8_SCHED;
            PG8_LDB(B1, 1, 1); PG8_STAGE(PG8_SB(1, 0), b3, voffB);
            PG8_BAR; PG8_WAIT_L(0); PG8_MMA(0, 1, At, B1); PG8_BAR;
            PG8_LDA(At, 1, 1); PG8_STAGE(PG8_SA(1, 0), a3, voffA);
            PG8_BAR; PG8_WAIT_L(0); PG8_MMA(1, 0, At, B0); PG8_BAR; PG8_SCHED;
            PG8_STAGE(PG8_SB(1, 1), b3 + hstep, voffB);
            PG8_WAIT_V(6); PG8_BAR; PG8_MMA(1, 1, At, B1); PG8_BAR;
            }
        }
        if constexpr (ALIGN_EPI) { if (wr == 0) PG8_BAR; }
        if constexpr (!Epi::AFTER_DRAIN) { E(acc, cur, wr, wc, fr, fq); S.done(cur); }
        if (!has_next) break;
#pragma unroll
        for (int a = 0; a < 2; ++a)
#pragma unroll
            for (int b = 0; b < 2; ++b)
#pragma unroll
                for (int m = 0; m < 4; ++m)
#pragma unroll
                    for (int n = 0; n < 2; ++n) acc[a][b][m][n] = (f32x4){0.f, 0.f, 0.f, 0.f};
        cur = nxt; cA = nA; cB = nB; ++ui;
        if constexpr (ALIGN_EPI) { if (wr == 1) PG8_BAR; }
    }
    PG8_WAIT_V(0);
    if constexpr (!ALIGN_EPI) { if (wr == 0) PG8_BAR; }
    PG8_BAR;
    if constexpr (Epi::AFTER_DRAIN) { E.fused(acc, cur, wr, wc, fr, fq, lds, wid, lane); S.done(cur); }
#undef PG8_SA
#undef PG8_SB
#undef PG8_STAGE
#undef PG8_LDA
#undef PG8_LDB
#undef PG8_MMA
#undef PG8_WAIT_V
#undef PG8_WAIT_L
#undef PG8_BAR
#undef PG8_SCHED
}
}

namespace att {
using bf16 = __hip_bfloat16;
constexpr int   D = 128, NW = 8, QBLK = 32, KVBLK = 64;
constexpr float SCALE = 0.088388347648318440f;
constexpr float THR = 8.f;
constexpr int SDEPTH = 1;
constexpr int LDQ = 1024, LDK = 256, LDO = 1024;
constexpr size_t SHM_V = KVBLK * D * 2, SHM_K = KVBLK * D * 2, SHM_ATTN = 2 * SHM_V + 2 * SHM_K + NW * 64 * 4;
using bf16x8 = __attribute__((ext_vector_type(8))) short;
using s16x4  = __attribute__((ext_vector_type(4))) short;
using f32x16 = __attribute__((ext_vector_type(16))) float;
using f32x8  = __attribute__((ext_vector_type(8))) float;
using u32x4  = __attribute__((ext_vector_type(4))) unsigned;
#define KSWZ(row, colB) ((row) * 256 + ((colB) ^ (((row) & 7) << 4)))
#define SBAR() __builtin_amdgcn_sched_barrier(0)
__device__ __forceinline__ int crow(int r, int hi) { return (r & 3) + 8 * (r >> 2) + 4 * hi; }
__device__ __forceinline__ unsigned cvtpk(float lo, float hi) {
  unsigned r; asm volatile("v_cvt_pk_bf16_f32 %0, %1, %2" : "=v"(r) : "v"(lo), "v"(hi)); return r;
}
template <typename TIn> struct Stage;
template <> struct Stage<bf16>  { using T = bf16x8;
  __device__ static __forceinline__ T ld8(const bf16* p) { return *reinterpret_cast<const bf16x8*>(p); }
  __device__ static __forceinline__ bf16x8 tobf(T x) { return x; } };
__device__ __forceinline__ void partialSM(f32x16& p0, f32x16& p1, float& m_reg, float& mn, float& alpha) {
  constexpr float C = SCALE * 1.4426950408889634f;
  float pmax = p0[0]; for (int r = 1; r < 16; ++r) pmax = fmaxf(pmax, p0[r]); for (int r = 0; r < 16; ++r) pmax = fmaxf(pmax, p1[r]);
  { auto rr = __builtin_amdgcn_permlane32_swap(__float_as_uint(pmax), __float_as_uint(pmax), false, false);
    pmax = fmaxf(__uint_as_float(rr[0]), __uint_as_float(rr[1])); }
  if (__builtin_expect(__all(pmax - m_reg <= THR / SCALE), 1)) { mn = m_reg; alpha = 1.f; }
  else { mn = fmaxf(m_reg, pmax); alpha = __builtin_amdgcn_exp2f((m_reg - mn) * C); m_reg = mn; }
  float mnC = -mn * C;
  for (int r = 0; r < 16; ++r) p0[r] = fmaf(p0[r], C, mnC); for (int r = 0; r < 16; ++r) p1[r] = fmaf(p1[r], C, mnC);
  for (int r = 0; r < 16; ++r) p0[r] = __builtin_amdgcn_exp2f(p0[r]);
}
__device__ __forceinline__ void finishSM(f32x16& p0, f32x16& p1, float alpha, float& l_reg, bf16x8& pa0, bf16x8& pa1, bf16x8& pa2, bf16x8& pa3) {
  for (int r = 0; r < 16; ++r) p1[r] = __builtin_amdgcn_exp2f(p1[r]);
  float ps = 0; for (int r = 0; r < 16; ++r) ps += p0[r]; for (int r = 0; r < 16; ++r) ps += p1[r];
  { auto rr = __builtin_amdgcn_permlane32_swap(__float_as_uint(ps), __float_as_uint(ps), false, false);
    ps = __uint_as_float(rr[0]) + __uint_as_float(rr[1]); }
  l_reg = l_reg * alpha + ps;
#define PK4(P, BASE, OUT) do { unsigned a0 = cvtpk(P[BASE + 0], P[BASE + 1]), a1 = cvtpk(P[BASE + 2], P[BASE + 3]);   \
    unsigned b0 = cvtpk(P[BASE + 4], P[BASE + 5]), b1 = cvtpk(P[BASE + 6], P[BASE + 7]);                              \
    auto r0 = __builtin_amdgcn_permlane32_swap(a0, b0, false, false); auto r1 = __builtin_amdgcn_permlane32_swap(a1, b1, false, false); \
    u32x4 w = {r0[0], r1[0], r0[1], r1[1]}; OUT = *reinterpret_cast<bf16x8*>(&w); } while (0)
  PK4(p0, 0, pa0); PK4(p0, 8, pa1); PK4(p1, 0, pa2); PK4(p1, 8, pa3);
#undef PK4
}
__device__ __forceinline__ void qkt(f32x16& p0, f32x16& p1, const bf16* Ks, const bf16x8* qr, int r32, int hi) {
  p0 = f32x16{}; p1 = f32x16{};
  for (int d0 = 0; d0 < 8; ++d0) { int cb = (d0 * 16 + hi * 8) * 2;
    bf16x8 b0 = *reinterpret_cast<const bf16x8*>((const char*)Ks + KSWZ(r32, cb));
    bf16x8 b1 = *reinterpret_cast<const bf16x8*>((const char*)Ks + KSWZ(32 + r32, cb));
    p0 = __builtin_amdgcn_mfma_f32_32x32x16_bf16(b0, qr[d0], p0, 0, 0, 0);
    p1 = __builtin_amdgcn_mfma_f32_32x32x16_bf16(b1, qr[d0], p1, 0, 0, 0); }
}
__device__ __forceinline__ int v_st(int k, int c) { const int kk = (k & ~0xC) | ((k & 4) << 1) | ((k & 8) >> 1); return ((kk >> 3) * 4 + (c >> 5)) * 512 + ((kk & 7) * 32 + (c & 31)) * 2; }
__device__ __forceinline__ int v_rd_base(int lane) { return ((lane & 3) << 3) | (((lane >> 2) & 3) << 6) | (((lane >> 4) & 1) << 5) | (((lane >> 5) & 1) << 8); }
constexpr int v_rd_off(int d0, int ks, int half) { return d0 * 512 + ks * 4096 + half * 2048; }
template <int OFF> __device__ __forceinline__ s16x4 tr_read(int vb) {
  s16x4 r; asm volatile("ds_read_b64_tr_b16 %0, %1 offset:%2" : "=&v"(r) : "v"(vb), "i"(OFF) : "memory"); return r;
}
template <int D0> __device__ __forceinline__ void pv_one(f32x16& od, int vb, bf16x8 pa0, bf16x8 pa1, bf16x8 pa2, bf16x8 pa3) {
  const s16x4 l0 = tr_read<v_rd_off(D0, 0, 0)>(vb), h0 = tr_read<v_rd_off(D0, 0, 1)>(vb), l1 = tr_read<v_rd_off(D0, 1, 0)>(vb), h1 = tr_read<v_rd_off(D0, 1, 1)>(vb);
  const s16x4 l2 = tr_read<v_rd_off(D0, 2, 0)>(vb), h2 = tr_read<v_rd_off(D0, 2, 1)>(vb), l3 = tr_read<v_rd_off(D0, 3, 0)>(vb), h3 = tr_read<v_rd_off(D0, 3, 1)>(vb);
  asm volatile("s_waitcnt lgkmcnt(0)" ::: "memory"); SBAR();
#define PK(L, H) (bf16x8){L[0], L[1], L[2], L[3], H[0], H[1], H[2], H[3]}
  od = __builtin_amdgcn_mfma_f32_32x32x16_bf16(pa0, PK(l0, h0), od, 0, 0, 0);
  od = __builtin_amdgcn_mfma_f32_32x32x16_bf16(pa1, PK(l1, h1), od, 0, 0, 0);
  od = __builtin_amdgcn_mfma_f32_32x32x16_bf16(pa2, PK(l2, h2), od, 0, 0, 0);
  od = __builtin_amdgcn_mfma_f32_32x32x16_bf16(pa3, PK(l3, h3), od, 0, 0, 0);
#undef PK
}
__device__ __forceinline__ void pv_d0(f32x16* o, int vb, bf16x8 pa0, bf16x8 pa1, bf16x8 pa2, bf16x8 pa3) {
  pv_one<0>(o[0], vb, pa0, pa1, pa2, pa3); pv_one<1>(o[1], vb, pa0, pa1, pa2, pa3); pv_one<2>(o[2], vb, pa0, pa1, pa2, pa3); pv_one<3>(o[3], vb, pa0, pa1, pa2, pa3);
}
template <typename TQ>
__device__ __forceinline__ void attn_dense_body(const TQ* __restrict__ Qb, const bf16* __restrict__ Kh, const bf16* __restrict__ Vh,
                                                unsigned short* __restrict__ Ob, int seq, char* lds, int wv) {
  using St = Stage<bf16>; using SQ = Stage<TQ>;
  const int tid = ltid(wv), wid = tid >> 6, lane = tid & 63, r32 = lane & 31, hi = lane >> 5;
  bf16* V_lds = (bf16*)lds; bf16* K_lds = (bf16*)(lds + 2 * SHM_V);
  float* ws = (float*)(lds + 2 * SHM_V + 2 * SHM_K) + wid * 64; float* li_l = ws; float* al_l = ws + 32;
  float m_reg = -1e30f, l_reg = 0; f32x16 o[4] = {}; bf16x8 qr[8];
  const TQ* Qw = Qb + (long)(wid * QBLK + r32) * LDQ + hi * 8;
#pragma unroll
  for (int d0 = 0; d0 < 8; ++d0) qr[d0] = SQ::tobf(SQ::ld8(Qw + d0 * 16));
  const int sr = tid >> 4, sc = (tid & 15) * 8, vst0 = v_st(sr, sc), vst1 = v_st(32 + sr, sc);
  const int vb0 = (int)(uintptr_t)V_lds + v_rd_base(lane);
  struct { typename St::T vs0, vs1, ks0, ks1; } sr_[SDEPTH];
#define SLOAD(i, k0) do { sr_[i].vs0 = St::ld8(&Vh[(long)((k0) + sr) * LDK + sc]); sr_[i].vs1 = St::ld8(&Vh[(long)((k0) + 32 + sr) * LDK + sc]); \
    sr_[i].ks0 = St::ld8(&Kh[(long)((k0) + sr) * LDK + sc]); sr_[i].ks1 = St::ld8(&Kh[(long)((k0) + 32 + sr) * LDK + sc]); } while (0)
#define SWRITE(b, i) do { *(bf16x8*)((char*)V_lds + (b) * SHM_V + vst0) = St::tobf(sr_[i].vs0);          \
    *(bf16x8*)((char*)V_lds + (b) * SHM_V + vst1) = St::tobf(sr_[i].vs1); int kc = sc * 2;               \
    *(bf16x8*)((char*)K_lds + (b) * SHM_K + KSWZ(sr, kc)) = St::tobf(sr_[i].ks0);                       \
    *(bf16x8*)((char*)K_lds + (b) * SHM_K + KSWZ(32 + sr, kc)) = St::tobf(sr_[i].ks1); } while (0)
#define SWAIT() do { if constexpr (SDEPTH == 2) asm volatile("s_waitcnt vmcnt(4)" ::: "memory"); else asm volatile("s_waitcnt vmcnt(0)" ::: "memory"); } while (0)
#define RESC(a) do { if (__any((a) < 1.f)) { if (hi == 0) al_l[r32] = (a); asm volatile("s_waitcnt lgkmcnt(0)" ::: "memory"); \
    for (int d = 0; d < 4; ++d) for (int r = 0; r < 16; ++r) o[d][r] *= al_l[crow(r, hi)]; } } while (0)
  f32x16 pA0, pA1, pB0, pB1; float mnA, mnB, alA, alB; bf16x8 pa0, pa1, pa2, pa3; const int NT = seq / KVBLK;
  constexpr int SE = 0, SO = SDEPTH - 1;
  SLOAD(SE, 0); asm volatile("s_waitcnt vmcnt(0)" ::: "memory"); SWRITE(0, SE); __syncthreads();
  qkt(pA0, pA1, K_lds, qr, r32, hi); partialSM(pA0, pA1, m_reg, mnA, alA);
  SLOAD(SO, KVBLK); if constexpr (SDEPTH == 2) { if (2 < NT) SLOAD(SE, 2 * KVBLK); }
  SWAIT(); SWRITE(1, SO); __syncthreads();
  for (int j = 1; j + 1 < NT; j += 2) {
    SBAR(); qkt(pB0, pB1, (bf16*)((char*)K_lds + SHM_K), qr, r32, hi);
    finishSM(pA0, pA1, alA, l_reg, pa0, pa1, pa2, pa3); SBAR();
    SLOAD(SO, (j + SDEPTH) * KVBLK); SBAR();
    pv_d0(o, vb0, pa0, pa1, pa2, pa3); partialSM(pB0, pB1, m_reg, mnB, alB);
    __syncthreads(); SWAIT(); SWRITE(0, SE);
    RESC(alB); __syncthreads();
    SBAR(); qkt(pA0, pA1, K_lds, qr, r32, hi);
    finishSM(pB0, pB1, alB, l_reg, pa0, pa1, pa2, pa3); SBAR();
    if (SDEPTH == 1 || j + 3 < NT) SLOAD(SE, (j + 1 + SDEPTH) * KVBLK); SBAR();
    pv_d0(o, vb0 + (int)SHM_V, pa0, pa1, pa2, pa3); partialSM(pA0, pA1, m_reg, mnA, alA);
    __syncthreads(); SWAIT(); SWRITE(1, SO);
    RESC(alA); __syncthreads();
  }
  SBAR(); qkt(pB0, pB1, (bf16*)((char*)K_lds + SHM_K), qr, r32, hi);
  finishSM(pA0, pA1, alA, l_reg, pa0, pa1, pa2, pa3); SBAR();
  pv_d0(o, vb0, pa0, pa1, pa2, pa3); partialSM(pB0, pB1, m_reg, mnB, alB);
  __syncthreads(); RESC(alB);
  finishSM(pB0, pB1, alB, l_reg, pa0, pa1, pa2, pa3); SBAR();
  pv_d0(o, vb0 + (int)SHM_V, pa0, pa1, pa2, pa3);
  if (hi == 0) li_l[r32] = l_reg; asm volatile("s_waitcnt lgkmcnt(0)" ::: "memory");
  float rli[16];
#pragma unroll
  for (int r = 0; r < 16; ++r) rli[r] = __builtin_amdgcn_rcpf(li_l[crow(r, hi)]);
  unsigned short* Ow = Ob + (long)(wid * QBLK) * LDO;
#pragma unroll
  for (int r = 0; r < 16; ++r) { int orow = crow(r, hi);
    for (int d0 = 0; d0 < 4; ++d0) Ow[(long)orow * LDO + d0 * 32 + r32] = (unsigned short)(cvtpk(o[d0][r] * rli[r], 0.f) & 0xffffu); }
#undef SLOAD
#undef SWRITE
#undef SWAIT
#undef RESC
}
}

#define LAS __attribute__((address_space(3)))
typedef unsigned short u16;
typedef short bf16x8 __attribute__((ext_vector_type(8)));
typedef float f32x4 __attribute__((ext_vector_type(4)));
typedef float f32x16 __attribute__((ext_vector_type(16)));
typedef unsigned u32x4 __attribute__((ext_vector_type(4)));
typedef unsigned u32x2 __attribute__((ext_vector_type(2)));

constexpr int M = 12288, MP = 4096, DM = 1024, FF = 2816, NMOD = 9216;
constexpr size_t HM = 524288;
constexpr size_t WS_MOD = 0, WS_ROPE = 262144, WS_AB = 2 * HM, WS_GC = 6 * HM;
constexpr size_t WS_WIN11 = 8 * HM, WS_WOUT11 = 30 * HM, WS_WDNO = 41 * HM, WS_WDNIN = 45 * HM, WS_WIN10 = 62 * HM, WS_WOUT10 = 84 * HM;
constexpr size_t WS_WIN00 = 95 * HM, WS_WIN01 = 117 * HM, WS_WOUT00 = 139 * HM, WS_WOUT01 = 150 * HM, WS_WQKV = 161 * HM, WS_WO = 167 * HM;
constexpr size_t WS_XN = 171 * HM, WS_BIG = 219 * HM;
constexpr size_t WS_G = WS_BIG;
constexpr size_t WS_Q = WS_BIG, WS_O = WS_BIG + 48 * HM, WS_KB = WS_BIG + 96 * HM, WS_VB = WS_BIG + 110 * HM;
constexpr size_t WS_QKVR = WS_BIG, WS_Z = WS_BIG + 144 * HM, WS_U = WS_BIG + 192 * HM, WS_QN = WS_BIG + 288 * HM, WS_W = 62 * HM, WS_KN = 158 * HM;
constexpr size_t WS_OF = WS_BIG + 48 * HM, WS_OB = WS_BIG + 96 * HM, WS_O2 = WS_BIG;
constexpr size_t WS_END = WS_QN + 48 * HM;
constexpr int OUT_NK = 12582912, OUT_NV = 13631488, OUT_SF = 14680064, OUT_SB = 16777216;
constexpr int LDS_BYTES = 147456, LDS_RED = 131072, LDS_BARST = 147392;
constexpr size_t WS_CTL = 524288, CTL_BYTES = 131072;
constexpr size_t WS_XBUF = 786432;

struct Params { const float* in[30]; float* out; unsigned char* ws; };

__device__ __forceinline__ unsigned cvtpk(float lo, float hi) { return cvtpk_rne(lo, hi); }
__device__ __forceinline__ u16 f2bf(float f) { return (u16)(cvtpk(f, 0.f) & 0xffffu); }
__device__ __forceinline__ float bflo(unsigned w) { return __uint_as_float(w << 16); }
__device__ __forceinline__ float bfhi(unsigned w) { return __uint_as_float(w & 0xffff0000u); }
__device__ __forceinline__ float silu(float x) { return x * __builtin_amdgcn_rcpf(1.0f + __expf(-x)); }
__device__ __forceinline__ float wave_sum(float v) {
#pragma unroll
    for (int o = 1; o < 64; o <<= 1) v += __shfl_xor(v, o);
    return v;
}
__device__ __forceinline__ int crow(int r, int hi) { return (r & 3) + 8 * (r >> 2) + 4 * hi; }
template <int KSTEPS> __device__ __forceinline__ void mm_tile(f32x16& acc, const LAS char* A, int sA, const LAS char* Bt, int sB, int r32, int hi) {
    bf16x8 a[KSTEPS], b[KSTEPS];
#pragma unroll
    for (int ks = 0; ks < KSTEPS; ++ks) { a[ks] = *(const LAS bf16x8*)(A + r32 * sA + (ks * 16 + hi * 8) * 2); b[ks] = *(const LAS bf16x8*)(Bt + r32 * sB + (ks * 16 + hi * 8) * 2); }
#pragma unroll
    for (int ks = 0; ks < KSTEPS; ++ks) acc = __builtin_amdgcn_mfma_f32_32x32x16_bf16(a[ks], b[ks], acc, 0, 0, 0);
}

__device__ __forceinline__ int map_col(int mode, int r) {
    if (mode == 1) { const int pn = r >> 8, w = r & 255; return w < 128 ? pn * 128 + w : FF + pn * 128 + (w - 128); }
    if (mode == 2) { if (r < 1280) { const int b4 = (r >> 4) & 1, b5 = (r >> 5) & 1; return (r & ~48) | (b4 << 5) | (b5 << 4); } return r; }
    return r;
}
__device__ __forceinline__ void transpose_item(const float* W, int K, int Nsrc, u16* WT, int mode, LAS float* scr, int item, int nblk, int lane) {
    const int kb = item / nblk, nb = item % nblk, k0 = 64 * kb, n0 = 64 * nb;
    const int r = lane >> 4, cg = lane & 15, sc = map_col(mode, n0 + 4 * cg);
#pragma unroll 8
    for (int i = 0; i < 16; ++i) { const int kk = 4 * i + r; const f32x4 v = *(const f32x4*)(W + (size_t)(k0 + kk) * Nsrc + sc);
        LAS float* d = scr + kk * 65 + 4 * cg; d[0] = v[0]; d[1] = v[1]; d[2] = v[2]; d[3] = v[3]; }
    asm volatile("s_waitcnt lgkmcnt(0)" ::: "memory");
    const int c = lane & 7;
#pragma unroll
    for (int j = 0; j < 8; ++j) { const int n = (lane >> 3) + 8 * j; const LAS float* s = scr + (8 * c) * 65 + n;
        u32x4 o; o.x = cvtpk(s[0 * 65], s[1 * 65]); o.y = cvtpk(s[2 * 65], s[3 * 65]); o.z = cvtpk(s[4 * 65], s[5 * 65]); o.w = cvtpk(s[6 * 65], s[7 * 65]);
        *(u32x4*)(WT + (size_t)(n0 + n) * K + k0 + 8 * c) = o; }
    asm volatile("s_waitcnt lgkmcnt(0)" ::: "memory");
}
__device__ __forceinline__ int seg_items(int sgm) { return (sgm == 0 || sgm == 4 || sgm == 8 || sgm == 10) ? 1408 : (sgm == 1 || sgm == 5 || sgm == 9 || sgm == 11) ? 704 : sgm == 2 ? 384 : sgm == 6 ? 1024 : 256; }
__device__ __forceinline__ void seg_item(const Params& P, int sgm, int r, LAS float* scr, int lane) {
    unsigned char* ws = P.ws;
    switch (sgm) {
        case 0:  transpose_item(P.in[11], DM, 2 * FF, (u16*)(ws + WS_WIN00), 1, scr, r, 88, lane); break;
        case 1:  transpose_item(P.in[12], FF, DM, (u16*)(ws + WS_WOUT00), 0, scr, r, 16, lane); break;
        case 2:  transpose_item(P.in[14], DM, 1536, (u16*)(ws + WS_WQKV), 2, scr, r, 24, lane); break;
        case 3:  transpose_item(P.in[17], DM, DM, (u16*)(ws + WS_WO), 0, scr, r, 16, lane); break;
        case 4:  transpose_item(P.in[27], DM, 2 * FF, (u16*)(ws + WS_WIN01), 1, scr, r, 88, lane); break;
        case 5:  transpose_item(P.in[28], FF, DM, (u16*)(ws + WS_WOUT01), 0, scr, r, 16, lane); break;
        case 6:  transpose_item(P.in[18], DM, 4096, (u16*)(ws + WS_WDNIN), 0, scr, r, 64, lane); break;
        case 7:  transpose_item(P.in[25], DM, DM, (u16*)(ws + WS_WDNO), 0, scr, r, 16, lane); break;
        case 8:  transpose_item(P.in[11] + (size_t)DM * 2 * FF, DM, 2 * FF, (u16*)(ws + WS_WIN10), 1, scr, r, 88, lane); break;
        case 9:  transpose_item(P.in[12] + (size_t)FF * DM, FF, DM, (u16*)(ws + WS_WOUT10), 0, scr, r, 16, lane); break;
        case 10: transpose_item(P.in[27] + (size_t)DM * 2 * FF, DM, 2 * FF, (u16*)(ws + WS_WIN11), 1, scr, r, 88, lane); break;
        default: transpose_item(P.in[28] + (size_t)FF * DM, FF, DM, (u16*)(ws + WS_WOUT11), 0, scr, r, 16, lane); break;
    }
}
__device__ __forceinline__ void copy_items_range(const Params& P, LAS char* lds, int seg0, int it_lo, int it_hi, int worker, int nworkers, int lane, int wid) {
    LAS float* scr = (LAS float*)(lds + wid * 16640);
    for (int it = it_lo + worker; it < it_hi; it += nworkers) { int r = it, sgm = seg0;
        while (r >= seg_items(sgm)) { r -= seg_items(sgm); ++sgm; }
        seg_item(P, sgm, r, scr, lane); }
}
__device__ __forceinline__ void copy_items(const Params& P, LAS char* lds, int seg0, int seg1, int first_wg, int wv) {
    if ((int)blockIdx.x < first_wg) return;
    const int tid = ltid(wv), lane = tid & 63, wid = tid >> 6; int n = 0;
    for (int sgm = seg0; sgm < seg1; ++sgm) n += seg_items(sgm);
    copy_items_range(P, lds, seg0, 0, n, ((int)blockIdx.x - first_wg) * 8 + wid, ((int)gridDim.x - first_wg) * 8, lane, wid);
}
__device__ __forceinline__ void phase0(const Params& P, LAS char* lds, int wv) {
    const int tid = ltid(wv), lane = tid & 63, wid = tid >> 6, G = gridDim.x;
    unsigned char* ws = P.ws;
    if ((int)blockIdx.x < 144 || G < 144) {
      LAS float* sc = (LAS float*)lds;
      LAS float* red = (LAS float*)(lds + 16384);
      for (int i = tid; i < 3072; i += 512) { const int cnd = i >> 10, k = i & 1023; const float v = cnd == 0 ? P.in[7][k] : P.in[6][(cnd - 1) * 1024 + k]; sc[i] = silu(v); }
      __syncthreads();
      float* MOD = (float*)(ws + WS_MOD);
      for (int it = blockIdx.x; it < 144; it += G) {
          const int l = it / 72, cb = it % 72, cg = tid & 31, kp = tid >> 5;
          const float* W = P.in[8] + (size_t)l * DM * NMOD + cb * 128 + cg * 4;
          f32x4 a0 = {0.f, 0.f, 0.f, 0.f}, a1 = a0, a2 = a0;
#pragma unroll 16
          for (int k = kp * 64; k < kp * 64 + 64; ++k) { const f32x4 w = *(const f32x4*)(W + (size_t)k * NMOD); a0 += w * sc[k]; a1 += w * sc[1024 + k]; a2 += w * sc[2048 + k]; }
          LAS float* rp = red + (kp * 32 + cg) * 12;
#pragma unroll
          for (int j = 0; j < 4; ++j) { rp[j] = a0[j]; rp[4 + j] = a1[j]; rp[8 + j] = a2[j]; }
          __syncthreads();
          if (tid < 384) { const int c2 = tid & 127, cnd = tid >> 7; float s = P.in[9][l * NMOD + cb * 128 + c2];
#pragma unroll
              for (int q = 0; q < 16; ++q) s += red[(q * 32 + (c2 >> 2)) * 12 + cnd * 4 + (c2 & 3)];
              MOD[(l * 3 + cnd) * NMOD + cb * 128 + c2] = s; }
          __syncthreads();
      } }
    __syncthreads();
    {   const bool gemvwg = (int)blockIdx.x < 144 && G == 256;
        constexpr int NI = 1408 + 704, NSPLIT = NI;
        if (G == 256) { if (gemvwg) copy_items_range(P, lds, 0, NSPLIT, NI, (int)blockIdx.x * 8 + wid, 144 * 8, lane, wid); else copy_items_range(P, lds, 0, 0, NSPLIT, ((int)blockIdx.x - 144) * 8 + wid, 112 * 8, lane, wid); }
        else copy_items_range(P, lds, 0, 0, NI, (int)blockIdx.x * 8 + wid, G * 8, lane, wid);
    }
    { u16* WT = (u16*)(ws + WS_WDNIN); const float* wa = P.in[20]; const float* wb = P.in[23];
      for (int idx = blockIdx.x * 512 + tid; idx < 256 * 1024; idx += G * 512) {
          const int rr = idx >> 10, k = idx & 1023; float v = 0.f;
          if (rr < 16) v = wa[((rr >> 3) * 1024 + k) * 8 + (rr & 7)]; else if (rr < 32) v = wb[(((rr - 16) >> 3) * 1024 + k) * 8 + (rr & 7)];
          WT[(size_t)(4096 + rr) * 1024 + k] = f2bf(v); } }
    if (blockIdx.x == G - 1) { float* rope = (float*)(ws + WS_ROPE);
        for (int idx = tid; idx < 2048; idx += 512) { const int pos = idx >> 5, f = idx & 31;
            const float inv = exp2f(-(float)f * (13.287712379549449f / 32.0f)); const float ang = (float)pos * inv;
            rope[idx] = cosf(ang); rope[2048 + idx] = sinf(ang); } }
}

template <bool FIRST> __device__ __forceinline__ void normmod_phase(const Params& P, const float* gain, const float* modl, int ishift, int iscale, int wv) {
    const int lane = ltid(wv) & 63, gw = blockIdx.x * 8 + (ltid(wv) >> 6), NGW = gridDim.x * 8;
    u16* XN = (u16*)(P.ws + WS_XN); float* h = P.out;
    f32x4 gv[4];
#pragma unroll
    for (int j = 0; j < 4; ++j) gv[j] = *(const f32x4*)(gain + 4 * lane + 256 * j);
    for (int row0 = gw; row0 < M; row0 += 2 * NGW) {
        const int rowB = row0 + NGW < M ? row0 + NGW : row0; const bool hasB = row0 + NGW < M;
        f32x4 va[4], vb[4]; float sa = 0.f, sb = 0.f;
        { const float* srcA = FIRST ? (row0 < MP ? P.in[0] + (size_t)row0 * DM : P.in[1] + (size_t)(row0 - MP) * DM) : h + (size_t)row0 * DM;
          const float* srcB = FIRST ? (rowB < MP ? P.in[0] + (size_t)rowB * DM : P.in[1] + (size_t)(rowB - MP) * DM) : h + (size_t)rowB * DM;
#pragma unroll
          for (int j = 0; j < 4; ++j) { va[j] = *(const f32x4*)(srcA + 4 * lane + 256 * j); vb[j] = *(const f32x4*)(srcB + 4 * lane + 256 * j); }
#pragma unroll
          for (int j = 0; j < 4; ++j) { sa += (va[j][0] * va[j][0] + va[j][1] * va[j][1]) + (va[j][2] * va[j][2] + va[j][3] * va[j][3]); sb += (vb[j][0] * vb[j][0] + vb[j][1] * vb[j][1]) + (vb[j][2] * vb[j][2] + vb[j][3] * vb[j][3]); } }
        const float rinvA = 1.0f / sqrtf(wave_sum(sa) * (1.0f / DM) + 1e-6f), rinvB = 1.0f / sqrtf(wave_sum(sb) * (1.0f / DM) + 1e-6f);
#pragma unroll
        for (int t = 0; t < 2; ++t) { if (t == 1 && !hasB) break;
            const int row = t ? rowB : row0; const float rinv = t ? rinvB : rinvA;
            const int cond = row < MP ? 0 : (row < MP + 4096 ? 1 : 2);
            const float* sh = modl + cond * NMOD + ishift * 1024, * scl = modl + cond * NMOD + iscale * 1024;
#pragma unroll
            for (int j = 0; j < 4; ++j) {
                const f32x4 v = t ? vb[j] : va[j];
                if (FIRST) *(f32x4*)(h + (size_t)row * DM + 4 * lane + 256 * j) = v;
                const f32x4 sv = *(const f32x4*)(sh + 4 * lane + 256 * j), cv = *(const f32x4*)(scl + 4 * lane + 256 * j);
                const f32x4 y = v * rinv * gv[j] * (cv + 1.0f) + sv;
                u32x2 w; w.x = cvtpk(y[0], y[1]); w.y = cvtpk(y[2], y[3]);
                *(u32x2*)(XN + (size_t)row * DM + 4 * lane + 256 * j) = w;
            } }
    }
}
__device__ __forceinline__ void final_norm_phase(const Params& P, int wv) {
    const int lane = ltid(wv) & 63, gw = blockIdx.x * 8 + (ltid(wv) >> 6), NGW = gridDim.x * 8;
    float* h = P.out; const float* gain = P.in[29];
    f32x4 gv[4];
#pragma unroll
    for (int j = 0; j < 4; ++j) gv[j] = *(const f32x4*)(gain + 4 * lane + 256 * j);
    for (int row = gw; row < M; row += NGW) {
        float* src = h + (size_t)row * DM; f32x4 v[4]; float s = 0.f;
#pragma unroll
        for (int j = 0; j < 4; ++j) { v[j] = *(const f32x4*)(src + 4 * lane + 256 * j); s += (v[j][0] * v[j][0] + v[j][1] * v[j][1]) + (v[j][2] * v[j][2] + v[j][3] * v[j][3]); }
        const float rinv = 1.0f / sqrtf(wave_sum(s) * (1.0f / DM) + 1e-6f);
#pragma unroll
        for (int j = 0; j < 4; ++j) *(f32x4*)(src + 4 * lane + 256 * j) = v[j] * rinv * gv[j];
    }
}
__device__ __forceinline__ void cache_copy(const Params& P, int wv) {
    u16* KB = (u16*)(P.ws + WS_KB); u16* VB = (u16*)(P.ws + WS_VB);
    for (int i = blockIdx.x * 512 + ltid(wv); i < 2 * 2 * 512 * 64; i += gridDim.x * 512) {
        const int which = i >> 16, j = i & 65535, b = j >> 15, rem = j & 32767;
        const f32x4 v = *(const f32x4*)(P.in[which ? 3 : 2] + (size_t)b * 131072 + rem * 4);
        u32x2 w; w.x = cvtpk(v[0], v[1]); w.y = cvtpk(v[2], v[3]);
        *(u32x2*)((which ? VB : KB) + (size_t)(4096 + b * 4608) * 256 + rem * 4) = w;
    }
}

__device__ __forceinline__ void attn_phase(const Params& P, char* lds, int wv) {
    const att::bf16* Q = (const att::bf16*)(P.ws + WS_Q); const att::bf16* KB = (const att::bf16*)(P.ws + WS_KB); const att::bf16* VB = (const att::bf16*)(P.ws + WS_VB);
    u16* O = (u16*)(P.ws + WS_O);
    for (int u = blockIdx.x; u < 384; u += gridDim.x) {
        size_t qrow, krow; int head, kvh, seq;
        if (u < 256) { const int x = u & 7, i = u >> 3, pair = x >> 1, b = pair >> 1, sub = (x & 1) * 32 + i, qb = sub & 15; kvh = pair & 1; head = kvh * 4 + (sub >> 4);
            qrow = 4096 + (size_t)b * 4096 + qb * 256; krow = 4096 + (size_t)b * 4608; seq = 4608; }
        else { const int v = u - 256, b = v >> 3; head = v & 7; kvh = head >> 2; qrow = (size_t)b * 256; krow = qrow; seq = 256; }
        att::attn_dense_body<att::bf16>(Q + qrow * 1024 + head * 128, KB + krow * 256 + kvh * 128, VB + krow * 256 + kvh * 128, O + qrow * 1024 + head * 128, seq, lds, wv);
        __syncthreads();
    }
}

__device__ __forceinline__ void ab_tile_phase(const Params& P, LAS char* lds, int wv) {
    const int tid = ltid(wv), lane = tid & 63, wid = tid >> 6, r32 = lane & 31, hi = lane >> 5;
    const u16* XN = (const u16*)(P.ws + WS_XN); const u16* WT = (const u16*)(P.ws + WS_WDNIN) + (size_t)4096 * 1024; float* AB = (float*)(P.ws + WS_AB);
    LAS float* red = (LAS float*)lds;
    for (int blk = blockIdx.x; blk < 192; blk += gridDim.x) {
        const int row0 = blk * 64;
        f32x16 acc0 = {}, acc1 = {};
        bf16x8 a0[8], a1[8], b[8];
#pragma unroll
        for (int ks = 0; ks < 8; ++ks) { const int k = (wid * 8 + ks) * 16 + hi * 8;
            b[ks] = *(const bf16x8*)(WT + (size_t)r32 * 1024 + k);
            a0[ks] = *(const bf16x8*)(XN + (size_t)(row0 + r32) * 1024 + k); a1[ks] = *(const bf16x8*)(XN + (size_t)(row0 + 32 + r32) * 1024 + k); }
#pragma unroll
        for (int ks = 0; ks < 8; ++ks) { acc0 = __builtin_amdgcn_mfma_f32_32x32x16_bf16(a0[ks], b[ks], acc0, 0, 0, 0); acc1 = __builtin_amdgcn_mfma_f32_32x32x16_bf16(a1[ks], b[ks], acc1, 0, 0, 0); }
#pragma unroll
        for (int r = 0; r < 16; ++r) { red[((wid * 2 + 0) * 16 + r) * 64 + lane] = acc0[r]; red[((wid * 2 + 1) * 16 + r) * 64 + lane] = acc1[r]; }
        __syncthreads();
        for (int o = tid; o < 2048; o += 512) { float s = 0.f;
#pragma unroll
            for (int w = 0; w < 8; ++w) s += red[w * 2048 + o];
            const int mt = o >> 10, r = (o >> 6) & 15, l = o & 63;
            AB[(size_t)(row0 + mt * 32 + crow(r, l >> 5)) * 32 + (l & 31)] = s; }
        __syncthreads();
    }
}

__device__ __forceinline__ void conv8(const u16* p, bool hasPrev, bool hasNext, const float* cw, float (&out)[8]) {
    const u32x4 z = {0u, 0u, 0u, 0u};
    const u32x4 xc = *(const u32x4*)p, xp = hasPrev ? *(const u32x4*)(p - 3072) : z, xn = hasNext ? *(const u32x4*)(p + 3072) : z;
    const f32x4 w0a = *(const f32x4*)cw, w0b = *(const f32x4*)(cw + 4), w1a = *(const f32x4*)(cw + 3072), w1b = *(const f32x4*)(cw + 3076), w2a = *(const f32x4*)(cw + 6144), w2b = *(const f32x4*)(cw + 6148);
#pragma unroll
    for (int i = 0; i < 4; ++i) {
        const float w0l = i < 2 ? w0a[2 * i] : w0b[2 * i - 4], w0h = i < 2 ? w0a[2 * i + 1] : w0b[2 * i - 3];
        const float w1l = i < 2 ? w1a[2 * i] : w1b[2 * i - 4], w1h = i < 2 ? w1a[2 * i + 1] : w1b[2 * i - 3];
        const float w2l = i < 2 ? w2a[2 * i] : w2b[2 * i - 4], w2h = i < 2 ? w2a[2 * i + 1] : w2b[2 * i - 3];
        out[2 * i] = silu(bflo(xp[i]) * w0l + bflo(xc[i]) * w1l + bflo(xn[i]) * w2l);
        out[2 * i + 1] = silu(bfhi(xp[i]) * w0h + bfhi(xc[i]) * w1h + bfhi(xn[i]) * w2h);
    }
}
constexpr int D1_K = 0, D1_KT = 17408, D1_VT = 35840, D1_A0 = 54272, D1_A1 = 71680, D1_T = 89088, D1_GC = 125952;
__device__ __forceinline__ void d1_task(const Params& P, int ch, int h, LAS char* lds, int wv) {
    const int tid = ltid(wv), lane = tid & 63, wid = tid >> 6, r32 = lane & 31, hi = lane >> 5;
    unsigned char* ws = P.ws;
    const u16* QKVR = (const u16*)(ws + WS_QKVR); const float* AB = (const float*)(ws + WS_AB); float* GC = (float*)(ws + WS_GC);
    u16* QN = (u16*)(ws + WS_QN); u16* KN = (u16*)(ws + WS_KN); u16* U = (u16*)(ws + WS_U); u16* W = (u16*)(ws + WS_W);
    LAS char* Kl = lds + D1_K; LAS char* KTl = lds + D1_KT; LAS char* VTl = lds + D1_VT;
    LAS float* A0f = (LAS float*)(lds + D1_A0); LAS float* A1f = (LAS float*)(lds + D1_A1); LAS char* Tl = lds + D1_T;
    LAS float* gcl = (LAS float*)(lds + D1_GC); LAS float* betal = gcl + 128;
    const int r0 = ch * 64, seqlen = r0 < MP ? 256 : 4096;
    float ab_a = 0.f, ab_b = 0.f, dtb = 0.f, alg = 0.f;
    if (wid < 2) { const int row = r0 + lane; ab_a = AB[(size_t)row * 32 + wid * 8 + h]; ab_b = AB[(size_t)row * 32 + 16 + wid * 8 + h]; dtb = P.in[21][wid * 8 + h]; alg = P.in[22][wid * 8 + h]; }
    {
        const int c = tid >> 3, grp = tid & 7, row = r0 + c;
        const bool hasPrev = (row % seqlen) != 0, hasNext = ((row + 1) % seqlen) != 0;
        const u16* p = QKVR + (size_t)row * 3072 + h * 128 + grp * 16; const float* cw = P.in[19] + h * 128 + grp * 16;
        float qa[8], qb[8], ka[8], kb[8], va[8], vb[8];
        conv8(p, hasPrev, hasNext, cw, qa); conv8(p + 8, hasPrev, hasNext, cw + 8, qb);
        conv8(p + 1024, hasPrev, hasNext, cw + 1024, ka); conv8(p + 1032, hasPrev, hasNext, cw + 1032, kb);
        conv8(p + 2048, hasPrev, hasNext, cw + 2048, va); conv8(p + 2056, hasPrev, hasNext, cw + 2056, vb);
        float sq = 0.f, sk = 0.f;
#pragma unroll
        for (int i = 0; i < 8; ++i) { sq += qa[i] * qa[i] + qb[i] * qb[i]; sk += ka[i] * ka[i] + kb[i] * kb[i]; }
        sq += __shfl_xor(sq, 1); sq += __shfl_xor(sq, 2); sq += __shfl_xor(sq, 4);
        sk += __shfl_xor(sk, 1); sk += __shfl_xor(sk, 2); sk += __shfl_xor(sk, 4);
        const float rq = 0.088388347648318440f / sqrtf(sq + 1e-6f), rk = 1.0f / sqrtf(sk + 1e-6f);
        u32x4 q0, q1, w0, w1;
        q0.x = cvtpk(qa[0] * rq, qa[1] * rq); q0.y = cvtpk(qa[2] * rq, qa[3] * rq); q0.z = cvtpk(qa[4] * rq, qa[5] * rq); q0.w = cvtpk(qa[6] * rq, qa[7] * rq);
        q1.x = cvtpk(qb[0] * rq, qb[1] * rq); q1.y = cvtpk(qb[2] * rq, qb[3] * rq); q1.z = cvtpk(qb[4] * rq, qb[5] * rq); q1.w = cvtpk(qb[6] * rq, qb[7] * rq);
        w0.x = cvtpk(ka[0] * rk, ka[1] * rk); w0.y = cvtpk(ka[2] * rk, ka[3] * rk); w0.z = cvtpk(ka[4] * rk, ka[5] * rk); w0.w = cvtpk(ka[6] * rk, ka[7] * rk);
        w1.x = cvtpk(kb[0] * rk, kb[1] * rk); w1.y = cvtpk(kb[2] * rk, kb[3] * rk); w1.z = cvtpk(kb[4] * rk, kb[5] * rk); w1.w = cvtpk(kb[6] * rk, kb[7] * rk);
        { u16* dst = QN + (size_t)row * 1024 + h * 128 + grp * 16; *(u32x4*)dst = q0; *(u32x4*)(dst + 8) = q1; }
        { u16* dst = KN + (size_t)row * 1024 + h * 128 + grp * 16; *(u32x4*)dst = w0; *(u32x4*)(dst + 8) = w1; }
        *(LAS u32x4*)(Kl + c * 272 + grp * 32) = w0; *(LAS u32x4*)(Kl + c * 272 + grp * 32 + 16) = w1;
#pragma unroll
        for (int i = 0; i < 4; ++i) {
            *(LAS u16*)(KTl + (grp * 16 + 2 * i) * 144 + c * 2) = (u16)(w0[i] & 0xffffu); *(LAS u16*)(KTl + (grp * 16 + 2 * i + 1) * 144 + c * 2) = (u16)(w0[i] >> 16);
            *(LAS u16*)(KTl + (grp * 16 + 8 + 2 * i) * 144 + c * 2) = (u16)(w1[i] & 0xffffu); *(LAS u16*)(KTl + (grp * 16 + 9 + 2 * i) * 144 + c * 2) = (u16)(w1[i] >> 16); }
#pragma unroll
        for (int i = 0; i < 8; ++i) { *(LAS u16*)(VTl + (grp * 16 + i) * 144 + c * 2) = f2bf(va[i]); *(LAS u16*)(VTl + (grp * 16 + 8 + i) * 144 + c * 2) = f2bf(vb[i]); }
    }
    if (wid < 2) {
        const int dir = wid, c = lane, row = r0 + c;
        const float av = ab_a + dtb;
        const float sp = av > 20.f ? av : log1pf(expf(av));
        const float g = -expf(alg) * sp;
        const float bt = 1.0f / (1.0f + expf(-ab_b));
        float s = g;
#pragma unroll
        for (int off = 1; off < 64; off <<= 1) {
            const float t = dir == 0 ? __shfl_up(s, off) : __shfl_down(s, off);
            const bool ok = dir == 0 ? (lane >= off) : (lane + off < 64);
            if (ok) s += t;
        }
        gcl[dir * 64 + c] = s; betal[dir * 64 + c] = bt; GC[((size_t)dir * M + row) * 8 + h] = s;
    }
    __syncthreads();
    if (wid < 4) {
        const int mt = wid >> 1, nt = wid & 1; f32x16 acc = {};
        mm_tile<8>(acc, Kl + mt * 32 * 272, 272, Kl + nt * 32 * 272, 272, r32, hi);
        const int s = nt * 32 + r32; const float gs0 = gcl[s], gs1 = gcl[64 + s]; float g0v[16], g1v[16], b0v[16], b1v[16];
#pragma unroll
        for (int r = 0; r < 16; ++r) { const int c = mt * 32 + crow(r, hi); g0v[r] = gcl[c]; g1v[r] = gcl[64 + c]; b0v[r] = betal[c]; b1v[r] = betal[64 + c]; }
#pragma unroll
        for (int r = 0; r < 16; ++r) { const int c = mt * 32 + crow(r, hi); const float kk = acc[r];
            const float a0 = (c > s) ? b0v[r] * kk * __expf(fminf(g0v[r] - gs0, 0.f)) : 0.f;
            const float a1 = (c < s) ? b1v[r] * kk * __expf(fminf(g1v[r] - gs1, 0.f)) : 0.f;
            A0f[c * 68 + s] = a0; A1f[(63 - c) * 68 + (63 - s)] = a1; }
    }
    __syncthreads();
    if (wid < 2) {
        const int dir = wid, j = lane; LAS float* Af = dir ? A1f : A0f;
        for (int ib = 0; ib < 8; ++ib) {
            float s[8];
#pragma unroll
            for (int r = 0; r < 8; ++r) s[r] = (8 * ib + r == j) ? 1.f : 0.f;
#pragma unroll 2
            for (int m2 = 0; m2 < 8 * ib; m2 += 4) {
                const float x0 = Af[(m2 + 0) * 68 + j], x1 = Af[(m2 + 1) * 68 + j], x2 = Af[(m2 + 2) * 68 + j], x3 = Af[(m2 + 3) * 68 + j];
#pragma unroll
                for (int r = 0; r < 8; ++r) { const f32x4 a = *(const LAS f32x4*)(Af + (8 * ib + r) * 68 + m2); s[r] -= (a[0] * x0 + a[1] * x1) + (a[2] * x2 + a[3] * x3); }
            }
            f32x4 dl[8], dh[8];
#pragma unroll
            for (int r = 0; r < 8; ++r) { dl[r] = *(const LAS f32x4*)(Af + (8 * ib + r) * 68 + 8 * ib); dh[r] = *(const LAS f32x4*)(Af + (8 * ib + r) * 68 + 8 * ib + 4); }
#pragma unroll
            for (int r = 1; r < 8; ++r) {
#pragma unroll
                for (int q = 0; q < r; ++q) s[r] -= (q < 4 ? dl[r][q] : dh[r][q - 4]) * s[q];
            }
            asm volatile("s_waitcnt lgkmcnt(0)" ::: "memory");
#pragma unroll
            for (int r = 0; r < 8; ++r) Af[(8 * ib + r) * 68 + j] = s[r];
        }
    }
    __syncthreads();
    {
#pragma unroll 4
        for (int k = 0; k < 16; ++k) { const int idx = tid + 512 * k, dir = idx >> 12, c = (idx >> 6) & 63, s = idx & 63;
            const float t = dir ? A1f[(63 - c) * 68 + (63 - s)] : A0f[c * 68 + s];
            const float bs = betal[dir * 64 + s], bgs = bs * __expf(gcl[dir * 64 + s]);
            *(LAS u16*)(Tl + (dir * 2) * 9216 + c * 144 + s * 2) = f2bf(t * bs); *(LAS u16*)(Tl + (dir * 2 + 1) * 9216 + c * 144 + s * 2) = f2bf(t * bgs); }
    }
    __syncthreads();
    {
        const int dir = wid >> 2, kind = (wid >> 1) & 1, tbase = (wid & 1) * 4;
        const LAS char* Aop = kind ? KTl : VTl; const LAS char* Bop = Tl + (dir * 2 + kind) * 9216;
        const size_t tb = ((size_t)dir * 192 + ch) * 8 + h;
#pragma unroll
        for (int t = 0; t < 4; ++t) { const int tile = tbase + t, mt = tile >> 1, nt = tile & 1; f32x16 acc = {};
            mm_tile<4>(acc, Aop + mt * 32 * 144, 144, Bop + nt * 32 * 144, 144, r32, hi);
            if (kind == 0) { u16* dst = U + ((tb * 8 + tile) * 64 + lane) * 16; u32x4 w0, w1;
                w0.x = cvtpk(acc[0], acc[1]); w0.y = cvtpk(acc[2], acc[3]); w0.z = cvtpk(acc[4], acc[5]); w0.w = cvtpk(acc[6], acc[7]);
                w1.x = cvtpk(acc[8], acc[9]); w1.y = cvtpk(acc[10], acc[11]); w1.z = cvtpk(acc[12], acc[13]); w1.w = cvtpk(acc[14], acc[15]);
                *(u32x4*)dst = w0; *(u32x4*)(dst + 8) = w1; }
            else { const int c = nt * 32 + r32; u16* dst = W + (tb * 64 + c) * 128 + mt * 32 + 4 * hi;
#pragma unroll
                for (int q = 0; q < 4; ++q) { u32x2 w; w.x = cvtpk(acc[4 * q], acc[4 * q + 1]); w.y = cvtpk(acc[4 * q + 2], acc[4 * q + 3]); *(u32x2*)(dst + 8 * q) = w; } }
        }
    }
    __syncthreads();
}

constexpr int D2_ST = 0, D2_W = 17408, D2_Q = 34816, D2_K = 52224, D2_KT = 69632, D2_VN = 88064, D2_VN2 = 97280, D2_QK = 106496, D2_GC = 115712, D2_KT2OFF = 116224 - 69632;
__device__ __forceinline__ void d2_chain(const Params& P, int seq, int h, int dir, int vh, LAS char* lds, int wv) {
    const int tid = ltid(wv), lane = tid & 63, wid = tid >> 6, r32 = lane & 31, hi = lane >> 5;
    unsigned char* ws = P.ws;
    const u16* QN = (const u16*)(ws + WS_QN); const u16* KN = (const u16*)(ws + WS_KN); const u16* U = (const u16*)(ws + WS_U); const u16* W = (const u16*)(ws + WS_W);
    const float* GC = (const float*)(ws + WS_GC); u16* OX = (u16*)(ws + (dir ? WS_OB : WS_OF));
    LAS char* STl = lds + D2_ST; LAS char* Wl = lds + D2_W; LAS char* Ql = lds + D2_Q; LAS char* Kl = lds + D2_K; LAS char* KTl = lds + D2_KT;
    LAS char* VNl = lds + D2_VN; LAS char* VN2l = lds + D2_VN2; LAS char* QKl = lds + D2_QK; LAS float* gcl = (LAS float*)(lds + D2_GC);
    const bool samp = seq >= 16; const int rbase = samp ? MP + (seq - 16) * 4096 : seq * 256, nch = samp ? 64 : 4, ch0 = rbase >> 6;
    const int mtS = wid >> 2, ntS = wid & 3;
    const int mtl = (wid >> 1) & 1, ntc = wid & 1;
    f32x16 accS = {};
    if (samp) { const float* st = P.in[dir ? 5 : 4] + ((size_t)((seq - 16) * 8 + h) * 128) * 128 + (size_t)(ntS * 32 + r32) * 128 + vh * 64 + mtS * 32 + 4 * hi;
#pragma unroll
        for (int q = 0; q < 4; ++q) { const f32x4 t = *(const f32x4*)(st + 8 * q); accS[4 * q] = t[0]; accS[4 * q + 1] = t[1]; accS[4 * q + 2] = t[2]; accS[4 * q + 3] = t[3]; } }
    const int sc = tid >> 3, sg = tid & 7;
    u32x4 pq0, pq1, pk0, pk1, pw0, pw1, pu0 = {}, pu1 = {}; float pgc = 0.f;
#define D2_LOAD(n_) do { const int ch_ = ch0 + (dir ? nch - 1 - (n_) : (n_)); const size_t row_ = (size_t)ch_ * 64 + sc; \
        const u16* qp_ = QN + row_ * 1024 + h * 128 + sg * 16; pq0 = *(const u32x4*)qp_; pq1 = *(const u32x4*)(qp_ + 8); \
        const u16* kp_ = KN + row_ * 1024 + h * 128 + sg * 16; pk0 = *(const u32x4*)kp_; pk1 = *(const u32x4*)(kp_ + 8); \
        const size_t tb_ = ((size_t)dir * 192 + ch_) * 8 + h; \
        const u16* wp_ = W + (tb_ * 64 + sc) * 128 + sg * 16; pw0 = *(const u32x4*)wp_; pw1 = *(const u32x4*)(wp_ + 8); \
        if (wid < 4) { const u16* up_ = U + ((tb_ * 8 + (vh * 2 + mtl) * 2 + ntc) * 64 + lane) * 16; pu0 = *(const u32x4*)up_; pu1 = *(const u32x4*)(up_ + 8); } \
        if (tid < 64) pgc = GC[((size_t)dir * M + (size_t)ch_ * 64 + tid) * 8 + h]; } while (0)
    D2_LOAD(0);
    u32x4 u0, u1;
#define D2_STAGE_A() do { _Pragma("unroll") for (int r = 0; r < 16; ++r) *(LAS u16*)(STl + (mtS * 32 + crow(r, hi)) * 272 + (ntS * 32 + r32) * 2) = f2bf(accS[r]); \
        *(LAS u32x4*)(Ql + sc * 272 + sg * 32) = pq0; *(LAS u32x4*)(Ql + sc * 272 + sg * 32 + 16) = pq1; \
        *(LAS u32x4*)(Kl + sc * 272 + sg * 32) = pk0; *(LAS u32x4*)(Kl + sc * 272 + sg * 32 + 16) = pk1; \
        *(LAS u32x4*)(Wl + sc * 272 + sg * 32) = pw0; *(LAS u32x4*)(Wl + sc * 272 + sg * 32 + 16) = pw1; } while (0)
#define D2_STAGE_B(KT_, GC_) do { _Pragma("unroll") for (int i = 0; i < 4; ++i) { \
            *(LAS u16*)((KT_) + (sg * 16 + 2 * i) * 144 + sc * 2) = (u16)(pk0[i] & 0xffffu); *(LAS u16*)((KT_) + (sg * 16 + 2 * i + 1) * 144 + sc * 2) = (u16)(pk0[i] >> 16); \
            *(LAS u16*)((KT_) + (sg * 16 + 8 + 2 * i) * 144 + sc * 2) = (u16)(pk1[i] & 0xffffu); *(LAS u16*)((KT_) + (sg * 16 + 9 + 2 * i) * 144 + sc * 2) = (u16)(pk1[i] >> 16); } \
        if (tid < 64) (GC_)[tid] = pgc; u0 = pu0; u1 = pu1; } while (0)
    D2_STAGE_A(); D2_STAGE_B(KTl, gcl);
    __syncthreads();
    for (int n = 0; n < nch; ++n) {
        const int ch = ch0 + (dir ? nch - 1 - n : n);
        LAS char* KTc = KTl + (n & 1) * D2_KT2OFF; LAS char* KTn = KTl + ((n + 1) & 1) * D2_KT2OFF;
        LAS float* gcc = gcl + (n & 1) * 64; LAS float* gcn = gcl + ((n + 1) & 1) * 64;
        if (n + 1 < nch) D2_LOAD(n + 1);
        const float glast = gcc[dir ? 0 : 63];
        f32x16 acco = {};
        if (wid >= 4) {
            f32x16 acc = {}; mm_tile<8>(acc, Ql + mtl * 32 * 272, 272, Kl + ntc * 32 * 272, 272, r32, hi);
            const int s = ntc * 32 + r32; const float gs = gcc[s]; float gcv[16];
#pragma unroll
            for (int r = 0; r < 16; ++r) gcv[r] = gcc[mtl * 32 + crow(r, hi)];
#pragma unroll
            for (int r = 0; r < 16; ++r) { const int c = mtl * 32 + crow(r, hi); const bool valid = dir ? (c <= s) : (c >= s);
                const float val = valid ? acc[r] * __expf(fminf(gcv[r] - gs, 0.f)) : 0.f; *(LAS u16*)(QKl + c * 144 + s * 2) = f2bf(val); }
        } else {
            f32x16 acc = {}; mm_tile<8>(acc, STl + mtl * 32 * 272, 272, Wl + ntc * 32 * 272, 272, r32, hi);
            const int c = ntc * 32 + r32; const float e2 = __expf(glast - gcc[c]);
#pragma unroll
            for (int r = 0; r < 16; ++r) { const unsigned uw = r < 8 ? u0[r >> 1] : u1[(r - 8) >> 1]; const float uv = (r & 1) ? bfhi(uw) : bflo(uw);
                const float vn = uv - acc[r]; const int v = mtl * 32 + crow(r, hi);
                *(LAS u16*)(VNl + v * 144 + c * 2) = f2bf(vn); *(LAS u16*)(VN2l + v * 144 + c * 2) = f2bf(vn * e2); }
            mm_tile<8>(acco, STl + mtl * 32 * 272, 272, Ql + ntc * 32 * 272, 272, r32, hi);
            const float eg = __expf(gcc[c]);
#pragma unroll
            for (int r = 0; r < 16; ++r) acco[r] *= eg;
        }
        __syncthreads();
        if (wid < 4) {
            f32x16 acc = acco; const int c = ntc * 32 + r32;
            mm_tile<4>(acc, VNl + mtl * 32 * 144, 144, QKl + ntc * 32 * 144, 144, r32, hi);
            u16* dst = OX + ((size_t)ch * 64 + c) * 1024 + h * 128 + vh * 64 + mtl * 32 + 4 * hi;
#pragma unroll
            for (int q = 0; q < 4; ++q) { u32x2 w; w.x = cvtpk(acc[4 * q], acc[4 * q + 1]); w.y = cvtpk(acc[4 * q + 2], acc[4 * q + 3]); *(u32x2*)(dst + 8 * q) = w; }
        }
        {
            const float gl = __expf(glast);
#pragma unroll
            for (int r = 0; r < 16; ++r) accS[r] *= gl;
            mm_tile<4>(accS, VN2l + mtS * 32 * 144, 144, KTc + ntS * 32 * 144, 144, r32, hi);
        }
        if (n + 1 < nch) { D2_STAGE_A(); D2_STAGE_B(KTn, gcn); }
        __syncthreads();
    }
#undef D2_STAGE_A
#undef D2_STAGE_B
#undef D2_LOAD
    if (!samp) { float* dst = P.out + (dir ? OUT_SB : OUT_SF) + ((size_t)(seq * 8 + h) * 128 + ntS * 32 + r32) * 128 + vh * 64 + mtS * 32 + 4 * hi;
#pragma unroll
        for (int q = 0; q < 4; ++q) { f32x4 t; t[0] = accS[4 * q]; t[1] = accS[4 * q + 1]; t[2] = accS[4 * q + 2]; t[3] = accS[4 * q + 3]; *(f32x4*)(dst + 8 * q) = t; } }
}
__device__ __forceinline__ void d3_phase(const Params& P, int wv) {
    const int lane = ltid(wv) & 63, gw = blockIdx.x * 8 + (ltid(wv) >> 6), NGW = gridDim.x * 8;
    const u16* OF = (const u16*)(P.ws + WS_OF); const u16* OB = (const u16*)(P.ws + WS_OB); const u16* Z = (const u16*)(P.ws + WS_Z); u16* O2 = (u16*)(P.ws + WS_O2);
    const float* og = P.in[24] + (lane & 7) * 16;
    for (int row0 = gw; row0 < M; row0 += 2 * NGW) {
        const bool hasB = row0 + NGW < M; const int rowB = hasB ? row0 + NGW : row0;
        const size_t offA = (size_t)row0 * 1024 + lane * 16, offB = (size_t)rowB * 1024 + lane * 16;
        u32x4 ld[2][6];
        ld[0][0] = *(const u32x4*)(OF + offA); ld[0][1] = *(const u32x4*)(OF + offA + 8); ld[0][2] = *(const u32x4*)(OB + offA); ld[0][3] = *(const u32x4*)(OB + offA + 8); ld[0][4] = *(const u32x4*)(Z + offA); ld[0][5] = *(const u32x4*)(Z + offA + 8);
        ld[1][0] = *(const u32x4*)(OF + offB); ld[1][1] = *(const u32x4*)(OF + offB + 8); ld[1][2] = *(const u32x4*)(OB + offB); ld[1][3] = *(const u32x4*)(OB + offB + 8); ld[1][4] = *(const u32x4*)(Z + offB); ld[1][5] = *(const u32x4*)(Z + offB + 8);
#pragma unroll
        for (int t = 0; t < 2; ++t) { if (t == 1 && !hasB) break;
            const size_t off = t ? offB : offA;
            const u32x4 a0 = ld[t][0], a1 = ld[t][1], b0 = ld[t][2], b1 = ld[t][3], z0 = ld[t][4], z1 = ld[t][5];
            float v[16]; float s = 0.f;
#pragma unroll
            for (int i = 0; i < 4; ++i) { v[2 * i] = bflo(a0[i]) + bflo(b0[i]); v[2 * i + 1] = bfhi(a0[i]) + bfhi(b0[i]); v[8 + 2 * i] = bflo(a1[i]) + bflo(b1[i]); v[9 + 2 * i] = bfhi(a1[i]) + bfhi(b1[i]); }
#pragma unroll
            for (int i = 0; i < 16; ++i) s += v[i] * v[i];
            s += __shfl_xor(s, 1); s += __shfl_xor(s, 2); s += __shfl_xor(s, 4);
            const float rinv = 1.0f / sqrtf(s * (1.0f / 128.0f) + 1e-6f);
            u32x4 w0, w1;
#pragma unroll
            for (int i = 0; i < 4; ++i) {
                const float y0 = v[2 * i] * rinv * og[2 * i] * silu(bflo(z0[i])), y1 = v[2 * i + 1] * rinv * og[2 * i + 1] * silu(bfhi(z0[i]));
                const float y2 = v[8 + 2 * i] * rinv * og[8 + 2 * i] * silu(bflo(z1[i])), y3 = v[9 + 2 * i] * rinv * og[9 + 2 * i] * silu(bfhi(z1[i]));
                w0[i] = cvtpk(y0, y1); w1[i] = cvtpk(y2, y3); }
            *(u32x4*)(O2 + off) = w0; *(u32x4*)(O2 + off + 8) = w1;
        }
    }
}

#define XB_TMO      128
#define XB_XCNT(j)  (256  + 64 * (j))
#define XB_XSUB(j)  (1280 + 64 * (j))
#define XB_XGEN(j)  (2304 + 64 * (j))
#define XB_TOP      3328
#define XB_TOPGEN   3392
#define XCD_BAR_WORDS 3456
#define XB_SPIN_CAP (1u << 18)

__device__ __forceinline__ unsigned xb_ld(unsigned* p)              { return __hip_atomic_load(p, __ATOMIC_RELAXED, __HIP_MEMORY_SCOPE_AGENT); }
__device__ __forceinline__ unsigned xb_add(unsigned* p, unsigned v) { return __hip_atomic_fetch_add(p, v, __ATOMIC_RELAXED, __HIP_MEMORY_SCOPE_AGENT); }
__device__ __forceinline__ unsigned xb_xcc_id() { return (unsigned)__builtin_amdgcn_s_getreg((3 << 11) | 20) & 0xFu; }
#define XB_SPIN(cond, bar) do { unsigned _sp = 0; while (cond) { __builtin_amdgcn_s_sleep(1); \
    if ((++_sp & 255u) == 0u) { if (xb_ld(&(bar)[XB_TMO])) break; if (_sp > XB_SPIN_CAP) { atomicAdd(&(bar)[XB_TMO], 1u); break; } } } } while (0)

struct XcdBarrier {
    unsigned* bar; unsigned x;
    volatile LAS unsigned* st;
};

__device__ __forceinline__ XcdBarrier xcd_barrier_post(unsigned* bar, volatile LAS unsigned* st) {
    XcdBarrier b; b.bar = bar; b.x = xb_xcc_id(); b.st = st;
    if (threadIdx.x == 0) (void)xb_add(&bar[XB_XCNT(b.x)], 1u);
    return b;
}
__device__ __forceinline__ void xcd_barrier_complete(unsigned* bar, unsigned x, unsigned& nloc, unsigned& nx) {
    const unsigned G = gridDim.x * gridDim.y * gridDim.z;
    unsigned sum, cnt, mine, sp = 0u;
    for (;;) {
        sum = 0u; cnt = 0u; mine = 0u;
#pragma unroll
        for (unsigned j = 0; j < 16; ++j) { const unsigned c = xb_ld(&bar[XB_XCNT(j)]); sum += c; cnt += (c > 0u) ? 1u : 0u; mine = (j == x) ? c : mine; }
        if (sum == G) break;
        __builtin_amdgcn_s_sleep(1);
        if ((++sp & 255u) == 0u) { if (xb_ld(&bar[XB_TMO])) break; if (sp > XB_SPIN_CAP) { atomicAdd(&bar[XB_TMO], 1u); break; } }
    }
    nloc = mine > 0u ? mine : 1u; nx = cnt > 0u ? cnt : 1u;
}

__device__ __forceinline__ void xcd_barrier(const XcdBarrier& b) {
    asm volatile("s_waitcnt vmcnt(0)" ::: "memory");
    __syncthreads();
    if (threadIdx.x == 0) {
        unsigned* bar = b.bar;
        __builtin_amdgcn_s_waitcnt(0);
        unsigned nloc = b.st[0], nx = b.st[1];
        if (nloc == 0u) { xcd_barrier_complete(bar, b.x, nloc, nx); b.st[0] = nloc; b.st[1] = nx; }
        const unsigned old = xb_add(&bar[XB_XSUB(b.x)], 1u);
        const unsigned gen = old / nloc;
        if (old + 1u == (gen + 1u) * nloc) {
            __builtin_amdgcn_fence(__ATOMIC_RELEASE, "agent");
            asm volatile("s_waitcnt vmcnt(0)" ::: "memory");
            const unsigned og = xb_add(&bar[XB_TOP], 1u);
            const unsigned tg = og / nx;
            if (og + 1u == (tg + 1u) * nx) xb_add(&bar[XB_TOPGEN], 1u);
            else XB_SPIN(xb_ld(&bar[XB_TOPGEN]) == tg, bar);
            __builtin_amdgcn_fence(__ATOMIC_ACQUIRE, "agent");
            xb_add(&bar[XB_XGEN(b.x)], 1u);
            asm volatile("s_waitcnt vmcnt(0)" ::: "memory");
        } else {
            XB_SPIN(xb_ld(&bar[XB_XGEN(b.x)]) == gen, bar);
            __builtin_amdgcn_fence(__ATOMIC_ACQUIRE, "agent");
            asm volatile("s_waitcnt vmcnt(0)" ::: "memory");
        }
    }
    __syncthreads();
}

__device__ __forceinline__ void xcd_barrier_complete_n(unsigned* bar, unsigned x, unsigned& nloc, unsigned& nx, unsigned NG) {
    unsigned sum, cnt, mine, sp = 0u;
    for (;;) {
        sum = 0u; cnt = 0u; mine = 0u;
#pragma unroll
        for (unsigned j = 0; j < 16; ++j) { const unsigned c = xb_ld(&bar[XB_XCNT(j)]); sum += c; cnt += (c > 0u) ? 1u : 0u; mine = (j == x) ? c : mine; }
        if (sum == NG) break;
        __builtin_amdgcn_s_sleep(1);
        if ((++sp & 255u) == 0u) { if (xb_ld(&bar[XB_TMO])) break; if (sp > XB_SPIN_CAP) { atomicAdd(&bar[XB_TMO], 1u); break; } }
    }
    nloc = mine > 0u ? mine : 1u; nx = cnt > 0u ? cnt : 1u;
}
__device__ __forceinline__ void xcd_barrier_n(const XcdBarrier& b, unsigned NG) {
    asm volatile("s_waitcnt vmcnt(0)" ::: "memory");
    __syncthreads();
    if (threadIdx.x == 0) {
        unsigned* bar = b.bar;
        __builtin_amdgcn_s_waitcnt(0);
        unsigned nloc = b.st[0], nx = b.st[1];
        if (nloc == 0u) { xcd_barrier_complete_n(bar, b.x, nloc, nx, NG); b.st[0] = nloc; b.st[1] = nx; }
        const unsigned old = xb_add(&bar[XB_XSUB(b.x)], 1u);
        const unsigned gen = old / nloc;
        if (old + 1u == (gen + 1u) * nloc) {
            __builtin_amdgcn_fence(__ATOMIC_RELEASE, "agent");
            asm volatile("s_waitcnt vmcnt(0)" ::: "memory");
            const unsigned og = xb_add(&bar[XB_TOP], 1u);
            const unsigned tg = og / nx;
            if (og + 1u == (tg + 1u) * nx) xb_add(&bar[XB_TOPGEN], 1u);
            else XB_SPIN(xb_ld(&bar[XB_TOPGEN]) == tg, bar);
            __builtin_amdgcn_fence(__ATOMIC_ACQUIRE, "agent");
            xb_add(&bar[XB_XGEN(b.x)], 1u);
            asm volatile("s_waitcnt vmcnt(0)" ::: "memory");
        } else {
            XB_SPIN(xb_ld(&bar[XB_XGEN(b.x)]) == gen, bar);
            __builtin_amdgcn_fence(__ATOMIC_ACQUIRE, "agent");
            asm volatile("s_waitcnt vmcnt(0)" ::: "memory");
        }
    }
    __syncthreads();
}

template <class Epi> __device__ __forceinline__ void run_gemm(LAS char* lds, const u16* A, const u16* Bt, int N, int K, const Epi& E, int wv) {
    pg8::Gemm g{A, Bt, M, N, K}; pg8::StaticOrder S; S.init(M, N, (int)gridDim.x, (int)blockIdx.x);
#ifndef SKIP_GEMM
    pg8::gemm_phase<Epi, pg8::StaticOrder, true, true>((PG8_LAS unsigned char*)lds, g, S, E, wv);
#endif
}
template <class Epi> __device__ __forceinline__ void run_gemm_fused(LAS char* lds, const u16* A, const u16* Bt, int N, int K, const Epi& E, int wv) {
    pg8::Gemm g{A, Bt, M, N, K}; pg8::StaticOrder S; S.init(M, N, (int)gridDim.x, (int)blockIdx.x);
    pg8::gemm_phase<Epi, pg8::StaticOrder, false, true>((PG8_LAS unsigned char*)lds, g, S, E, wv);
}
__device__ __forceinline__ void ffn_block(const XcdBarrier& bar, const Params& P, LAS char* lds, const float* modl, int mi, size_t w_in, size_t w_out,
                                          const float* ngain, const float* nmod, int nshift, int nscale, int bank, int wv, int ca0 = 0, int ca1 = 0, int cb0 = 0, int cb1 = 0) {
    unsigned char* ws = P.ws;
    { pg8::EpiSwiglu E{(u16*)(ws + WS_G), FF}; run_gemm(lds, (const u16*)(ws + WS_XN), (const u16*)(ws + w_in), 2 * FF, DM, E, wv); }
    if (ca1 > ca0 && gridDim.x == 256) copy_items(P, lds, ca0, ca1, 32, wv);
    xcd_barrier(bar);
    { pg8::EpiResidNorm E{P.out, modl + (mi + 2) * 1024, ngain, nmod, (u16*)(ws + WS_XN), (float*)(ws + WS_XBUF), (unsigned*)(ws + WS_CTL + 16384 + (size_t)bank * 12288), 0.5f, nshift, nscale, 0};
      run_gemm_fused(lds, (const u16*)(ws + WS_G), (const u16*)(ws + w_out), DM, FF, E, wv); }
    if (cb1 > cb0 && gridDim.x == 256) copy_items(P, lds, cb0, cb1, 192, wv);
    xcd_barrier(bar);
}

__global__ void __launch_bounds__(512, 2) fwd_megakernel(Params P) {
    extern __shared__ __attribute__((aligned(16))) unsigned char lds_raw[];
    LAS char* lds = (LAS char*)lds_raw;
    cg::grid_group grid = cg::this_grid();
    const int wv = __builtin_amdgcn_readfirstlane((int)(threadIdx.x >> 6));
    volatile LAS unsigned* bst = (volatile LAS unsigned*)(lds + LDS_BARST);
    if (threadIdx.x < 2) bst[threadIdx.x] = 0u;
    __syncthreads();
    if (threadIdx.x >= 2 && threadIdx.x < 4) bst[threadIdx.x] = 0u;
    __syncthreads();
    const XcdBarrier bar = xcd_barrier_post((unsigned*)(P.ws + WS_CTL), bst);
    XcdBarrier bar2; bar2.bar = (unsigned*)(P.ws + WS_CTL + 98304); bar2.x = bar.x; bar2.st = bst + 2;
    if (gridDim.x == 256 && blockIdx.x >= 64 && threadIdx.x == 0) (void)xb_add(&bar2.bar[XB_XCNT(bar2.x)], 1u);
    unsigned char* ws = P.ws;
    const float* MOD0 = (const float*)(ws + WS_MOD); const float* MOD1 = MOD0 + 3 * NMOD;
    float* XB = (float*)(ws + WS_XBUF);

    phase0(P, lds, wv);
    grid.sync();
    normmod_phase<true>(P, P.in[10], MOD0, 0, 1, wv);
    xcd_barrier(bar);
    ffn_block(bar, P, lds, MOD0, 0, WS_WIN00, WS_WOUT00, P.in[13], MOD0, 3, 4, 0, wv, 2, 6, 6, 8);
    if (gridDim.x != 256) { copy_items(P, lds, 2, 12, 0, wv); xcd_barrier(bar); }
    { pg8::EpiQKV E{(u16*)(ws + WS_Q), (u16*)(ws + WS_KB), (u16*)(ws + WS_VB), P.out + OUT_NK, P.out + OUT_NV, P.in[15], P.in[16], (const float*)(ws + WS_ROPE), (PG8_LAS float*)(lds + LDS_RED)};
      run_gemm(lds, (const u16*)(ws + WS_XN), (const u16*)(ws + WS_WQKV), 1536, DM, E, wv); }
    if (gridDim.x == 256) copy_items(P, lds, 8, 10, 32, wv);
    cache_copy(P, wv);
    xcd_barrier(bar);
    attn_phase(P, (char*)lds_raw, wv);
    xcd_barrier(bar);
    { pg8::EpiResidNorm E{P.out, MOD0 + 5 * 1024, P.in[26], MOD0, (u16*)(ws + WS_XN), XB, (unsigned*)(ws + WS_CTL + 16384 + 1 * 12288), 1.0f, 6, 7, 0};
      run_gemm_fused(lds, (const u16*)(ws + WS_O), (const u16*)(ws + WS_WO), DM, DM, E, wv); }
    xcd_barrier(bar);
    ffn_block(bar, P, lds, MOD0, 6, WS_WIN01, WS_WOUT01, P.in[10] + DM, MOD1, 0, 1, 2, wv, 10, 12, 0, 0);
    ffn_block(bar, P, lds, MOD1, 0, WS_WIN10, WS_WOUT10, P.in[13] + DM, MOD1, 3, 4, 3, wv);
    { pg8::EpiDN E{(u16*)(ws + WS_QKVR), (u16*)(ws + WS_Z), (float*)(ws + WS_AB)}; run_gemm(lds, (const u16*)(ws + WS_XN), (const u16*)(ws + WS_WDNIN), 4096, DM, E, wv); }
    ab_tile_phase(P, lds, wv);
    xcd_barrier(bar);
    if (gridDim.x == 256) {
        for (int t = blockIdx.x; t < 128 * 8; t += 256) d1_task(P, 64 + (t >> 3), t & 7, lds, wv);
        xcd_barrier(bar);
        if (blockIdx.x < 64) {
            const int t = blockIdx.x, rem = t & 31;
            d2_chain(P, 16 + (t >> 5), rem >> 2, (rem >> 1) & 1, rem & 1, lds, wv);
        } else {
            for (int t = blockIdx.x - 64; t < 64 * 8; t += 192) d1_task(P, t >> 3, t & 7, lds, wv);
            xcd_barrier_n(bar2, 192u);
            for (int t = blockIdx.x - 64; t < 512; t += 192) { const int rem = t & 31; d2_chain(P, t >> 5, rem >> 2, (rem >> 1) & 1, rem & 1, lds, wv); __syncthreads(); }
        }
    } else {
        for (int t = blockIdx.x; t < 192 * 8; t += gridDim.x) d1_task(P, t >> 3, t & 7, lds, wv);
        xcd_barrier(bar);
        for (int t = blockIdx.x; t < 576; t += gridDim.x) {
            int seq, rem;
            if (t < 64) { seq = 16 + (t >> 5); rem = t & 31; } else { seq = (t - 64) >> 5; rem = (t - 64) & 31; }
            d2_chain(P, seq, rem >> 2, (rem >> 1) & 1, rem & 1, lds, wv);
            __syncthreads();
        }
    }
    xcd_barrier(bar);
    d3_phase(P, wv);
    xcd_barrier(bar);
    { pg8::EpiResidNorm E{P.out, MOD1 + 5 * 1024, P.in[26] + DM, MOD1, (u16*)(ws + WS_XN), XB, (unsigned*)(ws + WS_CTL + 16384 + 4 * 12288), 1.0f, 6, 7, 0};
      run_gemm_fused(lds, (const u16*)(ws + WS_O2), (const u16*)(ws + WS_WDNO), DM, DM, E, wv); }
    xcd_barrier(bar);
    ffn_block(bar, P, lds, MOD1, 6, WS_WIN11, WS_WOUT11, P.in[29], MOD1, 0, -1, 5, wv);
}

extern "C" void kernel_launch(void* const* d_in, const int* in_sizes, int n_in, void* d_out, int out_size, void* d_ws, size_t ws_size, hipStream_t stream) {
    static int grid = 0;
    if (grid == 0) {
        if (n_in != 30 || out_size != 18874368 || ws_size < WS_END) { fprintf(stderr, "kernel_launch: unexpected shapes n_in %d out %d ws %zu (need %zu)\n", n_in, out_size, ws_size, (size_t)WS_END); grid = -1; return; }
        int dev = 0, cus = 0, per_cu = 0;
        hipGetDevice(&dev); hipDeviceGetAttribute(&cus, hipDeviceAttributeMultiprocessorCount, dev);
        if (hipFuncSetAttribute((const void*)fwd_megakernel, hipFuncAttributeMaxDynamicSharedMemorySize, LDS_BYTES) != hipSuccess) { fprintf(stderr, "kernel_launch: hipFuncSetAttribute failed\n"); grid = -1; return; }
        if (hipOccupancyMaxActiveBlocksPerMultiprocessor(&per_cu, (const void*)fwd_megakernel, 512, LDS_BYTES) != hipSuccess || per_cu < 1) { fprintf(stderr, "kernel_launch: occupancy query failed (%d)\n", per_cu); (void)hipGetLastError(); per_cu = 1; }
        grid = cus * 1;
    }
    if (grid < 0) return;
    if (hipMemsetAsync((char*)d_ws + WS_CTL, 0, CTL_BYTES, stream) != hipSuccess) { fprintf(stderr, "kernel_launch: memset failed\n"); return; }
    Params p{};
    for (int i = 0; i < 30; ++i) p.in[i] = (const float*)d_in[i];
    p.out = (float*)d_out; p.ws = (unsigned char*)d_ws;
    void* args[] = {&p};
    hipError_t e = hipLaunchCooperativeKernel((const void*)fwd_megakernel, dim3(grid), dim3(512), args, LDS_BYTES, stream);
    if (e != hipSuccess) fprintf(stderr, "cooperative launch failed: %s (grid %d)\n", hipGetErrorString(e), grid);
}
```

```cpp
#include <hip/hip_runtime.h>
#include <hip/hip_bf16.h>
#include <hip/hip_cooperative_groups.h>
#include <cstdio>
#include <cstdint>
namespace cg = cooperative_groups;
#ifndef REP_D2
#define REP_D2 0
#endif
#ifndef REP_ATT
#define REP_ATT 0
#endif
#ifndef REP_D1
#define REP_D1 0
#endif
#ifndef REP_G1
#define REP_G1 0
#endif
#ifndef REP_P0
#define REP_P0 0
#endif
#ifndef REP_NM
#define REP_NM 0
#endif
typedef __bf16 bf16x2_t __attribute__((ext_vector_type(2)));
typedef float f32x2_t __attribute__((ext_vector_type(2)));
__device__ __forceinline__ unsigned cvtpk_rne(float lo, float hi) { f32x2_t v = {lo, hi}; bf16x2_t b = __builtin_convertvector(v, bf16x2_t); return __builtin_bit_cast(unsigned, b); }
__device__ __forceinline__ int ltid(int wv) { int l; asm volatile("v_mbcnt_lo_u32_b32 %0, -1, 0\n\tv_mbcnt_hi_u32_b32 %0, -1, %0" : "=v"(l)); return (wv << 6) | l; }

namespace pg8 {
#define PG8_LAS __attribute__((address_space(3)))
typedef unsigned short bf16_t;
typedef short bf16x8 __attribute__((ext_vector_type(8)));
typedef float f32x4 __attribute__((ext_vector_type(4)));
typedef unsigned u32x4 __attribute__((ext_vector_type(4)));
constexpr int BM = 256, BK = 64, HALF = 128, HTB = HALF * BK * 2  , STAGE_BYTES = 8 * HTB, NXCD = 8, WGM = 8;

__host__ __device__ __forceinline__ int lds_byte(int r, int c) { const int st = (r >> 4) * 2 + (c >> 5), rr = r & 15, cc = c & 31, ob = rr * 64 + cc * 2; return st * 1024 + (ob ^ (((ob >> 9) & 1) << 5)); }
__host__ __device__ __forceinline__ void stage_rc(int b, int& R, int& C) { const int st = b / 1024, sb = b % 1024, swz = sb ^ (((sb >> 9) & 1) << 5); R = (st >> 1) * 16 + swz / 64; C = (st & 1) * 32 + (swz % 64) / 2; }
__host__ __device__ __forceinline__ int perm32(int rho) { const int n = rho >> 4, i = rho & 15; return 8 * (i >> 2) + 4 * n + (i & 3); }

struct Unit { int pm, pn; };
struct Gemm { const bf16_t* A; const bf16_t* Bt; int M, N, K; };

struct StaticOrder {
    int nM, nN, nwg, G, c;
    __host__ __device__ void init(int M, int N, int G_, int c_) { nM = M / BM; nN = N / BM; nwg = nM * nN; G = G_; c = c_; }
    __host__ __device__ bool next(int i, Unit& u) const {
        const long L = (long)i * G + c; if (L >= nwg) return false;
        int wgid = (int)L; { const int q = nwg / NXCD, r = nwg % NXCD, xcd = wgid % NXCD, off = wgid / NXCD; wgid = (xcd < r ? xcd * (q + 1) : r * (q + 1) + (xcd - r) * q) + off; }
        const int nig = WGM * nN, gid = wgid / nig, fm = gid * WGM, gsz = (nM - fm) < WGM ? (nM - fm) : WGM;
        u.pm = fm + ((wgid % nig) % gsz); u.pn = (wgid % nig) / gsz; return true;
    }
    __device__ __forceinline__ void a_ready(const Unit&) const {}
    __device__ __forceinline__ void done(const Unit&) const {}
};

__device__ __forceinline__ unsigned cvt_pk_bf16(float lo, float hi) { return cvtpk_rne(lo, hi); }
typedef unsigned u32x2 __attribute__((ext_vector_type(2)));
__device__ __forceinline__ float silu_f(float x) { return x * __builtin_amdgcn_rcpf(1.0f + __expf(-x)); }

struct EpiSwiglu {
    static constexpr bool PERM = true, AFTER_DRAIN = false;
    bf16_t* G; int ldg;
    __device__ __forceinline__ void operator()(const f32x4 (&acc)[2][2][4][2], const Unit& u, int wr, int wc, int fr, int fq) const {
        asm volatile("" : "+v"(fr), "+v"(fq));
        const int row0 = u.pm * BM + wr * 64 + fr, col0 = u.pn * HALF + wc * 32 + 8 * fq;
#pragma unroll
        for (int ai = 0; ai < 2; ++ai)
#pragma unroll
            for (int m = 0; m < 4; ++m) {
                bf16_t* rowp = G + (size_t)(row0 + ai * HALF + m * 16) * ldg + col0;
                const f32x4 a0 = acc[ai][0][m][0], a1 = acc[ai][0][m][1], b0 = acc[ai][1][m][0], b1 = acc[ai][1][m][1];
                f32x4 v0, v1;
#pragma unroll
                for (int j = 0; j < 4; ++j) { v0[j] = silu_f(a0[j]) * b0[j]; v1[j] = silu_f(a1[j]) * b1[j]; }
                u32x4 w; w.x = cvt_pk_bf16(v0[0], v0[1]); w.y = cvt_pk_bf16(v0[2], v0[3]); w.z = cvt_pk_bf16(v1[0], v1[1]); w.w = cvt_pk_bf16(v1[2], v1[3]);
                *(u32x4*)rowp = w;
            }
    }
};
struct EpiResid {
    static constexpr bool PERM = false, AFTER_DRAIN = false;
    float* h; const float* gate; float coef;
    __device__ __forceinline__ void operator()(const f32x4 (&acc)[2][2][4][2], const Unit& u, int wr, int wc, int fr, int fq) const {
        asm volatile("" : "+v"(fr), "+v"(fq));
        const int cond = u.pm < 16 ? 0 : (u.pm < 32 ? 1 : 2);
        const int row0 = u.pm * BM + wr * 64 + fr, col0 = u.pn * BM + wc * 32 + 4 * fq;
        const float* g = gate + cond * 9216 + col0;
        f32x4 gv[2][2];
#pragma unroll
        for (int bj = 0; bj < 2; ++bj)
#pragma unroll
            for (int n = 0; n < 2; ++n) gv[bj][n] = *(const f32x4*)(g + bj * HALF + n * 16) * coef;
#pragma unroll
        for (int ai = 0; ai < 2; ++ai)
#pragma unroll
            for (int m = 0; m < 4; ++m) { float* rowp = h + (size_t)(row0 + ai * HALF + m * 16) * 1024 + col0;
#pragma unroll
                for (int bj = 0; bj < 2; ++bj)
#pragma unroll
                    for (int n = 0; n < 2; ++n) { float* p = rowp + bj * HALF + n * 16; *(f32x4*)p = *(const f32x4*)p + gv[bj][n] * acc[ai][bj][m][n]; } }
    }
};

struct EpiResidNorm {
    static constexpr bool PERM = false, AFTER_DRAIN = true;
    float* h; const float* gate; const float* ngain; const float* nmod; bf16_t* XN; float* xbuf; unsigned* cnt; float coef; int ishift, iscale, pad_;
    __device__ __forceinline__ void operator()(const f32x4 (&)[2][2][4][2], const Unit&, int, int, int, int) const {}
    __device__ __forceinline__ void fused(f32x4 (&acc)[2][2][4][2], const Unit& u, int wr, int wc, int fr, int fq, PG8_LAS unsigned char* lds, int wid, int lane) const {
        float* const h_ = h; const float* const gate_ = gate; const float coef_ = coef; const float* const ngain_ = ngain; const float* const nmod_ = nmod; const int ishift_ = ishift, iscale_ = iscale; bf16_t* const XN_ = XN; float* const xbuf_ = xbuf; unsigned* const cnt_ = cnt;
        asm volatile("" : "+v"(fr), "+v"(fq));
        const int cond = u.pm < 16 ? 0 : (u.pm < 32 ? 1 : 2);
        const int row0 = u.pm * BM + wr * 64 + fr, col0 = u.pn * BM + wc * 32 + 4 * fq;
        PG8_LAS float* Pt = (PG8_LAS float*)lds; PG8_LAS float* St = Pt + 1024;
        {   const float* g = gate_ + cond * 9216 + col0;
            f32x4 gv[2][2];
#pragma unroll
            for (int bj = 0; bj < 2; ++bj)
#pragma unroll
                for (int n = 0; n < 2; ++n) gv[bj][n] = *(const f32x4*)(g + bj * HALF + n * 16) * coef_;
#pragma unroll
            for (int ai = 0; ai < 2; ++ai)
#pragma unroll
                for (int m = 0; m < 4; ++m) { float* rowp = h_ + (size_t)(row0 + ai * HALF + m * 16) * 1024 + col0; float s = 0.f;
#pragma unroll
                    for (int bj = 0; bj < 2; ++bj)
#pragma unroll
                        for (int n = 0; n < 2; ++n) { float* p = rowp + bj * HALF + n * 16; const f32x4 hv = *(const f32x4*)p + gv[bj][n] * acc[ai][bj][m][n];
                            acc[ai][bj][m][n] = hv; if (iscale_ >= 0) *(f32x4*)p = hv; s += (hv[0] * hv[0] + hv[1] * hv[1]) + (hv[2] * hv[2] + hv[3] * hv[3]); }
                    s += __shfl_xor(s, 16); s += __shfl_xor(s, 32);
                    if (fq == 0) Pt[(ai * HALF + wr * 64 + m * 16 + fr) * 4 + wc] = s;
                    asm volatile("" ::: "memory"); }
        }
        asm volatile("s_waitcnt lgkmcnt(0)" ::: "memory"); __builtin_amdgcn_s_barrier(); asm volatile("" ::: "memory");
        const int row = wid * 32 + (lane & 31);
        if (lane < 32) { const f32x4 p4 = *(const PG8_LAS f32x4*)(Pt + row * 4);
            __hip_atomic_store(xbuf_ + ((size_t)u.pm * BM + row) * 4 + u.pn, (p4[0] + p4[1]) + (p4[2] + p4[3]), __ATOMIC_RELAXED, __HIP_MEMORY_SCOPE_AGENT); }
        asm volatile("s_waitcnt vmcnt(0)" ::: "memory");
        if (lane == 0) __hip_atomic_fetch_add(cnt_ + 64 * u.pm, 1u, __ATOMIC_RELAXED, __HIP_MEMORY_SCOPE_AGENT);
        if (wid == 0) { unsigned sp = 0;
            while ((unsigned)__builtin_amdgcn_readfirstlane(__hip_atomic_load(cnt_ + 64 * u.pm, __ATOMIC_RELAXED, __HIP_MEMORY_SCOPE_AGENT)) < 32u) { __builtin_amdgcn_s_sleep(2); if (++sp > (1u << 22)) break; }
            __builtin_amdgcn_fence(__ATOMIC_ACQUIRE, "agent"); }
        asm volatile("s_waitcnt vmcnt(0) lgkmcnt(0)" ::: "memory"); __builtin_amdgcn_s_barrier(); asm volatile("" ::: "memory");
        if (lane < 32) { const float* sl = xbuf_ + ((size_t)u.pm * BM + row) * 4; float t = 0.f;
#pragma unroll
            for (int k = 0; k < 4; ++k) t += __hip_atomic_load(sl + k, __ATOMIC_RELAXED, __HIP_MEMORY_SCOPE_AGENT);
            St[row] = 1.0f / sqrtf(t * (1.0f / 1024.0f) + 1e-6f); }
        asm volatile("s_waitcnt vmcnt(0) lgkmcnt(0)" ::: "memory"); __builtin_amdgcn_s_barrier(); asm volatile("" ::: "memory");
        const float* gp = ngain_ + col0; const float* shp = nmod_ + cond * 9216 + (iscale_ >= 0 ? ishift_ : 0) * 1024 + col0; const float* scp = nmod_ + cond * 9216 + (iscale_ >= 0 ? iscale_ : 0) * 1024 + col0;
#pragma unroll
        for (int ai = 0; ai < 2; ++ai)
#pragma unroll
            for (int m = 0; m < 4; ++m) { const int r = ai * HALF + wr * 64 + m * 16 + fr; const float rinv = St[r]; const size_t off = (size_t)(u.pm * BM + r) * 1024 + col0;
#pragma unroll
                for (int bj = 0; bj < 2; ++bj)
#pragma unroll
                    for (int n = 0; n < 2; ++n) { const int co = bj * HALF + n * 16; const f32x4 gn = *(const f32x4*)(gp + co); f32x4 y = acc[ai][bj][m][n] * rinv * gn;
                        if (iscale_ >= 0) { const f32x4 sv = *(const f32x4*)(shp + co), cv = *(const f32x4*)(scp + co); y = y * (cv + 1.0f) + sv;
                            u32x2 w; w.x = cvt_pk_bf16(y[0], y[1]); w.y = cvt_pk_bf16(y[2], y[3]); *(u32x2*)(XN_ + off + co) = w; }
                        else *(f32x4*)(h_ + off + co) = y; }
                asm volatile("" ::: "memory"); }
    }
};
struct EpiQKV {
    static constexpr bool PERM = false, AFTER_DRAIN = false;
    bf16_t *Q, *KB, *VB; float *outk, *outv; const float *qg, *kg, *rope; PG8_LAS float* red;
    __device__ __forceinline__ void operator()(const f32x4 (&acc)[2][2][4][2], const Unit& u, int wr, int wc, int fr, int fq) const {
        asm volatile("" : "+v"(fr), "+v"(fq));
        const int pn = u.pn;
        if (pn < 5) {
#pragma unroll
            for (int ai = 0; ai < 2; ++ai)
#pragma unroll
                for (int m = 0; m < 4; ++m)
#pragma unroll
                    for (int bj = 0; bj < 2; ++bj) {
                        const f32x4 x = acc[ai][bj][m][0], y = acc[ai][bj][m][1];
                        float s = (x[0] * x[0] + x[1] * x[1]) + (x[2] * x[2] + x[3] * x[3]) + (y[0] * y[0] + y[1] * y[1]) + (y[2] * y[2] + y[3] * y[3]);
                        s += __shfl_xor(s, 16); s += __shfl_xor(s, 32);
                        if (fq == 0) red[((ai * HALF + wr * 64 + m * 16 + fr) * 2 + bj) * 4 + wc] = s;
                    }
            asm volatile("s_waitcnt lgkmcnt(0)" ::: "memory"); __builtin_amdgcn_s_barrier(); asm volatile("" ::: "memory");
            const float* gain = pn < 4 ? qg : kg;
            const int d0 = (wc >> 1) * 64 + (wc & 1) * 16 + fq * 4, f0 = (wc & 1) * 16 + fq * 4;
            const f32x4 g1 = *(const f32x4*)(gain + d0), g2 = *(const f32x4*)(gain + d0 + 32);
#pragma unroll
            for (int ai = 0; ai < 2; ++ai)
#pragma unroll
                for (int m = 0; m < 4; ++m) {
                    const int rl = ai * HALF + wr * 64 + m * 16 + fr, row = u.pm * BM + rl;
                    f32x4 cs = {1.f, 1.f, 1.f, 1.f}, sn = {0.f, 0.f, 0.f, 0.f};
                    if (u.pm >= 16) { const int t = (row - 4096) & 4095, pos = (wc >> 1) ? (t & 63) : (t >> 6);
                        cs = *(const f32x4*)(rope + pos * 32 + f0); sn = *(const f32x4*)(rope + 2048 + pos * 32 + f0); }
                    const int krow = row < 4096 ? row : 4096 + ((row - 4096) >> 12) * 4608 + 512 + ((row - 4096) & 4095);
#pragma unroll
                    for (int bj = 0; bj < 2; ++bj) {
                        const f32x4 pr = *(const PG8_LAS f32x4*)(red + (rl * 2 + bj) * 4);
                        const float rinv = __builtin_amdgcn_rsqf(((pr[0] + pr[1]) + (pr[2] + pr[3])) * (1.0f / 128.0f) + 1e-6f);
                        const f32x4 x1 = acc[ai][bj][m][0] * rinv * g1, x2 = acc[ai][bj][m][1] * rinv * g2;
                        const f32x4 o1 = x1 * cs - x2 * sn, o2 = x2 * cs + x1 * sn;
                        u32x2 w1, w2; w1.x = cvt_pk_bf16(o1[0], o1[1]); w1.y = cvt_pk_bf16(o1[2], o1[3]); w2.x = cvt_pk_bf16(o2[0], o2[1]); w2.y = cvt_pk_bf16(o2[2], o2[3]);
                        if (pn < 4) { bf16_t* dst = Q + (size_t)row * 1024 + (pn * 2 + bj) * 128 + d0; *(u32x2*)dst = w1; *(u32x2*)(dst + 32) = w2; }
                        else { bf16_t* dst = KB + (size_t)krow * 256 + bj * 128 + d0; *(u32x2*)dst = w1; *(u32x2*)(dst + 32) = w2;
                            if (row < 4096) { float* ok = outk + (size_t)row * 256 + bj * 128 + d0; *(f32x4*)ok = o1; *(f32x4*)(ok + 32) = o2; } }
                    }
                    asm volatile("" ::: "memory");
                }
        } else {
#pragma unroll
            for (int ai = 0; ai < 2; ++ai)
#pragma unroll
                for (int m = 0; m < 4; ++m) {
                    const int row = u.pm * BM + ai * HALF + wr * 64 + m * 16 + fr;
                    const int krow = row < 4096 ? row : 4096 + ((row - 4096) >> 12) * 4608 + 512 + ((row - 4096) & 4095);
#pragma unroll
                    for (int bj = 0; bj < 2; ++bj)
#pragma unroll
                        for (int n = 0; n < 2; ++n) {
                            const int c0 = bj * HALF + wc * 32 + n * 16 + 4 * fq; const f32x4 v = acc[ai][bj][m][n];
                            u32x2 w; w.x = cvt_pk_bf16(v[0], v[1]); w.y = cvt_pk_bf16(v[2], v[3]);
                            *(u32x2*)(VB + (size_t)krow * 256 + c0) = w;
                            if (row < 4096) *(f32x4*)(outv + (size_t)row * 256 + c0) = v;
                        }
                    asm volatile("" ::: "memory");
                }
        }
    }
};
struct EpiDN {
    static constexpr bool PERM = false, AFTER_DRAIN = false;
    bf16_t *QKV, *Z; float* AB;
    __device__ __forceinline__ void operator()(const f32x4 (&acc)[2][2][4][2], const Unit& u, int wr, int wc, int fr, int fq) const {
        asm volatile("" : "+v"(fr), "+v"(fq));
        const int pn = u.pn, row0 = u.pm * BM + wr * 64 + fr;
        if (pn < 16) {
            bf16_t* base = pn < 12 ? QKV : Z; const int ld = pn < 12 ? 3072 : 1024, colb = (pn < 12 ? pn : pn - 12) * BM + wc * 32 + 4 * fq;
#pragma unroll
            for (int ai = 0; ai < 2; ++ai)
#pragma unroll
                for (int m = 0; m < 4; ++m) { bf16_t* rowp = base + (size_t)(row0 + ai * HALF + m * 16) * ld + colb;
#pragma unroll
                    for (int bj = 0; bj < 2; ++bj)
#pragma unroll
                        for (int n = 0; n < 2; ++n) { const f32x4 v = acc[ai][bj][m][n]; u32x2 w; w.x = cvt_pk_bf16(v[0], v[1]); w.y = cvt_pk_bf16(v[2], v[3]); *(u32x2*)(rowp + bj * HALF + n * 16) = w; } }
        } else if (wc == 0) {
#pragma unroll
            for (int ai = 0; ai < 2; ++ai)
#pragma unroll
                for (int m = 0; m < 4; ++m) { float* rowp = AB + (size_t)(row0 + ai * HALF + m * 16) * 32 + 4 * fq;
#pragma unroll
                    for (int n = 0; n < 2; ++n) *(f32x4*)(rowp + n * 16) = acc[ai][0][m][n]; }
        }
    }
};
template <class Epi, class Sched, bool ALIGN_EPI = false, bool SP2 = false>
__device__ __forceinline__ void gemm_phase(PG8_LAS unsigned char* lds, const Gemm g, const Sched& S, const Epi& E, int wv) {
    const int tid = ltid(wv), wid = __builtin_amdgcn_readfirstlane(tid >> 6), lane = tid & 63, wr = wid >> 2, wc = wid & 3, fr = lane & 15, fq = lane >> 4;
    const int K = g.K, nt = K / BK;
    unsigned voffA[2], voffB[2];
#pragma unroll
    for (int i = 0; i < 2; ++i) { int R, C; stage_rc(tid * 16 + i * 8192, R, C); const int Rb = Epi::PERM ? ((R & ~31) + perm32(R & 31)) : R;
        voffA[i] = (unsigned)(R * K + C) * 2u; voffB[i] = (unsigned)(Rb * K + C) * 2u; }
    const size_t kstep = (size_t)(BK * 2);
    const size_t hstep = (size_t)HALF * K * 2;
    const size_t tstep = 2 * hstep;
    const unsigned ldsw = (unsigned)wid * 1024u;
    const int aoff = lds_byte(wr * 64 + fr, fq * 8), boff = lds_byte(wc * 32 + fr, fq * 8);
#define PG8_SA(b, h) (((b) * 2 + (h)) * HTB)
#define PG8_SB(b, h) ((4 + (b) * 2 + (h)) * HTB)
#define PG8_STAGE(bufoff, gbase, voff) do { _Pragma("unroll") for (int _i = 0; _i < 2; ++_i) \
        __builtin_amdgcn_global_load_lds((const unsigned*)((const char*)(gbase) + (voff)[_i]), (PG8_LAS unsigned*)(lds + (bufoff) + ldsw + _i * 8192), 16, 0, 0); } while (0)
#define PG8_LDA(dst, b, h) do { _Pragma("unroll") for (int m = 0; m < 4; ++m) _Pragma("unroll") for (int k = 0; k < 2; ++k) dst[m][k] = *(const PG8_LAS bf16x8*)(lds + PG8_SA(b, h) + aoff + m * 2048 + k * 1024); } while (0)
#define PG8_LDB(dst, b, h) do { _Pragma("unroll") for (int n = 0; n < 2; ++n) _Pragma("unroll") for (int k = 0; k < 2; ++k) dst[n][k] = *(const PG8_LAS bf16x8*)(lds + PG8_SB(b, h) + boff + n * 2048 + k * 1024); } while (0)
#define PG8_MMA(ai, bj, At, Bt) do { __builtin_amdgcn_s_setprio(1); _Pragma("unroll") for (int m = 0; m < 4; ++m) _Pragma("unroll") for (int n = 0; n < 2; ++n) _Pragma("unroll") for (int k = 0; k < 2; ++k) \
        acc[ai][bj][m][n] = __builtin_amdgcn_mfma_f32_16x16x32_bf16(Bt[n][k], At[m][k], acc[ai][bj][m][n], 0, 0, 0); __builtin_amdgcn_s_setprio(0); } while (0)
#define PG8_WAIT_V(n) asm volatile("s_waitcnt vmcnt(" #n ")" ::: "memory")
#define PG8_WAIT_L(n) asm volatile("s_waitcnt lgkmcnt(" #n ")" ::: "memory")
#define PG8_BAR __builtin_amdgcn_s_barrier()
#define PG8_SCHED __builtin_amdgcn_sched_barrier(0)
    Unit cur, nxt; int ui = 0;
    if (!S.next(0, cur)) return;
    f32x4 acc[2][2][4][2];
#pragma unroll
    for (int a = 0; a < 2; ++a)
#pragma unroll
        for (int b = 0; b < 2; ++b)
#pragma unroll
            for (int m = 0; m < 4; ++m)
#pragma unroll
                for (int n = 0; n < 2; ++n) acc[a][b][m][n] = (f32x4){0.f, 0.f, 0.f, 0.f};
    bf16x8 At[4][2], B0[2][2], B1[2][2];
    const char* cA = (const char*)g.A + (size_t)cur.pm * tstep; const char* cB = (const char*)g.Bt + (size_t)cur.pn * tstep;
    S.a_ready(cur);
    if constexpr (SP2) {
        PG8_STAGE(PG8_SB(0, 0), cB, voffB); PG8_STAGE(PG8_SB(0, 1), cB + hstep, voffB); PG8_STAGE(PG8_SA(0, 0), cA, voffA); PG8_STAGE(PG8_SA(0, 1), cA + hstep, voffA);
        if (wr == 1) PG8_BAR;
        PG8_WAIT_V(2); PG8_BAR;
        PG8_STAGE(PG8_SB(1, 0), cB + kstep, voffB); PG8_STAGE(PG8_SA(1, 0), cA + kstep, voffA); PG8_STAGE(PG8_SB(1, 1), cB + hstep + kstep, voffB);
        PG8_WAIT_V(6); PG8_BAR;
    } else {
        PG8_STAGE(PG8_SB(0, 0), cB, voffB); PG8_STAGE(PG8_SA(0, 0), cA, voffA); PG8_STAGE(PG8_SB(0, 1), cB + hstep, voffB); PG8_STAGE(PG8_SA(0, 1), cA + hstep, voffA);
        if (wr == 1) PG8_BAR;
        PG8_WAIT_V(4); PG8_BAR;
        PG8_STAGE(PG8_SB(1, 0), cB + kstep, voffB); PG8_STAGE(PG8_SA(1, 0), cA + kstep, voffA); PG8_STAGE(PG8_SB(1, 1), cB + hstep + kstep, voffB);
        PG8_WAIT_V(6); PG8_BAR;
    }
    for (;;) {
        const bool has_next = S.next(ui + 1, nxt);
        const char* nA = has_next ? (const char*)g.A + (size_t)nxt.pm * tstep : cA; const char* nB = has_next ? (const char*)g.Bt + (size_t)nxt.pn * tstep : cB;
        for (int t = 0; t < nt; t += 2) {
            const bool last = (t == nt - 2);
            const char* a1 = cA + (size_t)(t + 1) * kstep;
            const char* a2 = last ? nA : cA + (size_t)(t + 2) * kstep; const char* b2 = last ? nB : cB + (size_t)(t + 2) * kstep;
            const char* a3 = a2 + kstep; const char* b3 = b2 + kstep;
            if (last && has_next) S.a_ready(nxt);
            if constexpr (SP2) {
            PG8_LDB(B0, 0, 0); PG8_LDB(B1, 0, 1); PG8_SCHED; PG8_LDA(At, 0, 0); PG8_STAGE(PG8_SA(1, 1), a1 + hstep, voffA);
            PG8_WAIT_V(8); PG8_WAIT_L(0); PG8_BAR; PG8_MMA(0, 0, At, B0); PG8_MMA(0, 1, At, B1); PG8_BAR; PG8_SCHED;
            PG8_LDA(At, 0, 1); PG8_STAGE(PG8_SB(0, 0), b2, voffB); PG8_STAGE(PG8_SB(0, 1), b2 + hstep, voffB); PG8_STAGE(PG8_SA(0, 0), a2, voffA);
            PG8_WAIT_V(8); PG8_WAIT_L(0); PG8_BAR; PG8_MMA(1, 0, At, B0); PG8_MMA(1, 1, At, B1); PG8_BAR; PG8_SCHED;
            PG8_LDB(B0, 1, 0); PG8_LDB(B1, 1, 1); PG8_SCHED; PG8_LDA(At, 1, 0); PG8_STAGE(PG8_SA(0, 1), a2 + hstep, voffA);
            PG8_WAIT_V(8); PG8_WAIT_L(0); PG8_BAR; PG8_MMA(0, 0, At, B0); PG8_MMA(0, 1, At, B1); PG8_BAR; PG8_SCHED;
            PG8_LDA(At, 1, 1); PG8_STAGE(PG8_SB(1, 0), b3, voffB); PG8_STAGE(PG8_SB(1, 1), b3 + hstep, voffB); PG8_STAGE(PG8_SA(1, 0), a3, voffA);
            PG8_WAIT_V(8); PG8_WAIT_L(0); PG8_BAR; PG8_MMA(1, 0, At, B0); PG8_MMA(1, 1, At, B1); PG8_BAR; PG8_SCHED;
            } else {
            PG8_LDB(B0, 0, 0); PG8_SCHED; PG8_LDA(At, 0, 0); PG8_STAGE(PG8_SA(1, 1), a1 + hstep, voffA);
            PG8_WAIT_L(8); PG8_BAR; PG8_WAIT_L(0); PG8_MMA(0, 0, At, B0); PG8_BAR; PG8_SCHED;
            PG8_LDB(B1, 0, 1); PG8_STAGE(PG8_SB(0, 0), b2, voffB);
            PG8_BAR; PG8_WAIT_L(0); PG8_MMA(0, 1, At, B1); PG8_BAR;
            PG8_LDA(At, 0, 1); PG8_STAGE(PG8_SA(0, 0), a2, voffA);
            PG8_BAR; PG8_WAIT_L(0); PG8_MMA(1, 0, At, B0); PG8_BAR; PG8_SCHED;
            PG8_STAGE(PG8_SB(0, 1), b2 + hstep, voffB);
            PG8_WAIT_V(6); PG8_BAR; PG8_MMA(1, 1, At, B1); PG8_BAR;
            PG8_LDB(B0, 1, 0); PG8_SCHED; PG8_LDA(At, 1, 0); PG8_STAGE(PG8_SA(0, 1), a2 + hstep, voffA);
            PG8_WAIT_L(8); PG8_BAR; PG8_WAIT_L(0); PG8_MMA(0, 0, At, B0); PG8_BAR; PG8_SCHED;
            PG8_LDB(B1, 1, 1); PG8_STAGE(PG8_SB(1, 0), b3, voffB);
            PG8_BAR; PG8_WAIT_L(0); PG8_MMA(0, 1, At, B1); PG8_BAR;
            PG8_LDA(At, 1, 1); PG8_STAGE(PG8_SA(1, 0), a3, voffA);
            PG8_BAR; PG8_WAIT_L(0); PG8_MMA(1, 0, At, B0); PG8_BAR; PG8_SCHED;
            PG8_STAGE(PG8_SB(1, 1), b3 + hstep, voffB);
            PG8_WAIT_V(6); PG8_BAR; PG8_MMA(1, 1, At, B1); PG8_BAR;
            }
        }
        if constexpr (ALIGN_EPI) { if (wr == 0) PG8_BAR; }
        if constexpr (!Epi::AFTER_DRAIN) { E(acc, cur, wr, wc, fr, fq); S.done(cur); }
        if (!has_next) break;
#pragma unroll
        for (int a = 0; a < 2; ++a)
#pragma unroll
            for (int b = 0; b < 2; ++b)
#pragma unroll
                for (int m = 0; m < 4; ++m)
#pragma unroll
                    for (int n = 0; n < 2; ++n) acc[a][b][m][n] = (f32x4){0.f, 0.f, 0.f, 0.f};
        cur = nxt; cA = nA; cB = nB; ++ui;
        if constexpr (ALIGN_EPI) { if (wr == 1) PG8_BAR; }
    }
    PG8_WAIT_V(0);
    if constexpr (!ALIGN_EPI) { if (wr == 0) PG8_BAR; }
    PG8_BAR;
    if constexpr (Epi::AFTER_DRAIN) { E.fused(acc, cur, wr, wc, fr, fq, lds, wid, lane); S.done(cur); }
#undef PG8_SA
#undef PG8_SB
#undef PG8_STAGE
#undef PG8_LDA
#undef PG8_LDB
#undef PG8_MMA
#undef PG8_WAIT_V
#undef PG8_WAIT_L
#undef PG8_BAR
#undef PG8_SCHED
}
}

namespace att {
using bf16 = __hip_bfloat16;
constexpr int   D = 128, NW = 8, QBLK = 32, KVBLK = 64;
constexpr float SCALE = 0.088388347648318440f;
constexpr float THR = 8.f;
constexpr int SDEPTH = 1;
constexpr int LDQ = 1024, LDK = 256, LDO = 1024;
constexpr size_t SHM_V = KVBLK * D * 2, SHM_K = KVBLK * D * 2, SHM_ATTN = 2 * SHM_V + 2 * SHM_K + NW * 64 * 4;
using bf16x8 = __attribute__((ext_vector_type(8))) short;
using s16x4  = __attribute__((ext_vector_type(4))) short;
using f32x16 = __attribute__((ext_vector_type(16))) float;
using f32x8  = __attribute__((ext_vector_type(8))) float;
using u32x4  = __attribute__((ext_vector_type(4))) unsigned;
#define KSWZ(row, colB) ((row) * 256 + ((colB) ^ (((row) & 7) << 4)))
#define SBAR() __builtin_amdgcn_sched_barrier(0)
__device__ __forceinline__ int crow(int r, int hi) { return (r & 3) + 8 * (r >> 2) + 4 * hi; }
__device__ __forceinline__ unsigned cvtpk(float lo, float hi) {
  unsigned r; asm volatile("v_cvt_pk_bf16_f32 %0, %1, %2" : "=v"(r) : "v"(lo), "v"(hi)); return r;
}
template <typename TIn> struct Stage;
template <> struct Stage<bf16>  { using T = bf16x8;
  __device__ static __forceinline__ T ld8(const bf16* p) { return *reinterpret_cast<const bf16x8*>(p); }
  __device__ static __forceinline__ bf16x8 tobf(T x) { return x; } };
__device__ __forceinline__ void partialSM(f32x16& p0, f32x16& p1, float& m_reg, float& mn, float& alpha) {
  constexpr float C = SCALE * 1.4426950408889634f;
  float pmax = p0[0]; for (int r = 1; r < 16; ++r) pmax = fmaxf(pmax, p0[r]); for (int r = 0; r < 16; ++r) pmax = fmaxf(pmax, p1[r]);
  { auto rr = __builtin_amdgcn_permlane32_swap(__float_as_uint(pmax), __float_as_uint(pmax), false, false);
    pmax = fmaxf(__uint_as_float(rr[0]), __uint_as_float(rr[1])); }
  if (__builtin_expect(__all(pmax - m_reg <= THR / SCALE), 1)) { mn = m_reg; alpha = 1.f; }
  else { mn = fmaxf(m_reg, pmax); alpha = __builtin_amdgcn_exp2f((m_reg - mn) * C); m_reg = mn; }
  float mnC = -mn * C;
  for (int r = 0; r < 16; ++r) p0[r] = fmaf(p0[r], C, mnC); for (int r = 0; r < 16; ++r) p1[r] = fmaf(p1[r], C, mnC);
  for (int r = 0; r < 16; ++r) p0[r] = __builtin_amdgcn_exp2f(p0[r]);
}
__device__ __forceinline__ void finishSM(f32x16& p0, f32x16& p1, float alpha, float& l_reg, bf16x8& pa0, bf16x8& pa1, bf16x8& pa2, bf16x8& pa3) {
  for (int r = 0; r < 16; ++r) p1[r] = __builtin_amdgcn_exp2f(p1[r]);
  float ps = 0; for (int r = 0; r < 16; ++r) ps += p0[r]; for (int r = 0; r < 16; ++r) ps += p1[r];
  { auto rr = __builtin_amdgcn_permlane32_swap(__float_as_uint(ps), __float_as_uint(ps), false, false);
    ps = __uint_as_float(rr[0]) + __uint_as_float(rr[1]); }
  l_reg = l_reg * alpha + ps;
#define PK4(P, BASE, OUT) do { unsigned a0 = cvtpk(P[BASE + 0], P[BASE + 1]), a1 = cvtpk(P[BASE + 2], P[BASE + 3]);   \
    unsigned b0 = cvtpk(P[BASE + 4], P[BASE + 5]), b1 = cvtpk(P[BASE + 6], P[BASE + 7]);                              \
    auto r0 = __builtin_amdgcn_permlane32_swap(a0, b0, false, false); auto r1 = __builtin_amdgcn_permlane32_swap(a1, b1, false, false); \
    u32x4 w = {r0[0], r1[0], r0[1], r1[1]}; OUT = *reinterpret_cast<bf16x8*>(&w); } while (0)
  PK4(p0, 0, pa0); PK4(p0, 8, pa1); PK4(p1, 0, pa2); PK4(p1, 8, pa3);
#undef PK4
}
__device__ __forceinline__ void qkt(f32x16& p0, f32x16& p1, const bf16* Ks, const bf16x8* qr, int r32, int hi) {
  p0 = f32x16{}; p1 = f32x16{};
  for (int d0 = 0; d0 < 8; ++d0) { int cb = (d0 * 16 + hi * 8) * 2;
    bf16x8 b0 = *reinterpret_cast<const bf16x8*>((const char*)Ks + KSWZ(r32, cb));
    bf16x8 b1 = *reinterpret_cast<const bf16x8*>((const char*)Ks + KSWZ(32 + r32, cb));
    p0 = __builtin_amdgcn_mfma_f32_32x32x16_bf16(b0, qr[d0], p0, 0, 0, 0);
    p1 = __builtin_amdgcn_mfma_f32_32x32x16_bf16(b1, qr[d0], p1, 0, 0, 0); }
}
__device__ __forceinline__ int v_st(int k, int c) { const int kk = (k & ~0xC) | ((k & 4) << 1) | ((k & 8) >> 1); return ((kk >> 3) * 4 + (c >> 5)) * 512 + ((kk & 7) * 32 + (c & 31)) * 2; }
__device__ __forceinline__ int v_rd_base(int lane) { return ((lane & 3) << 3) | (((lane >> 2) & 3) << 6) | (((lane >> 4) & 1) << 5) | (((lane >> 5) & 1) << 8); }
constexpr int v_rd_off(int d0, int ks, int half) { return d0 * 512 + ks * 4096 + half * 2048; }
template <int OFF> __device__ __forceinline__ s16x4 tr_read(int vb) {
  s16x4 r; asm volatile("ds_read_b64_tr_b16 %0, %1 offset:%2" : "=&v"(r) : "v"(vb), "i"(OFF) : "memory"); return r;
}
template <int D0> __device__ __forceinline__ void pv_one(f32x16& od, int vb, bf16x8 pa0, bf16x8 pa1, bf16x8 pa2, bf16x8 pa3) {
  const s16x4 l0 = tr_read<v_rd_off(D0, 0, 0)>(vb), h0 = tr_read<v_rd_off(D0, 0, 1)>(vb), l1 = tr_read<v_rd_off(D0, 1, 0)>(vb), h1 = tr_read<v_rd_off(D0, 1, 1)>(vb);
  const s16x4 l2 = tr_read<v_rd_off(D0, 2, 0)>(vb), h2 = tr_read<v_rd_off(D0, 2, 1)>(vb), l3 = tr_read<v_rd_off(D0, 3, 0)>(vb), h3 = tr_read<v_rd_off(D0, 3, 1)>(vb);
  asm volatile("s_waitcnt lgkmcnt(0)" ::: "memory"); SBAR();
#define PK(L, H) (bf16x8){L[0], L[1], L[2], L[3], H[0], H[1], H[2], H[3]}
  od = __builtin_amdgcn_mfma_f32_32x32x16_bf16(pa0, PK(l0, h0), od, 0, 0, 0);
  od = __builtin_amdgcn_mfma_f32_32x32x16_bf16(pa1, PK(l1, h1), od, 0, 0, 0);
  od = __builtin_amdgcn_mfma_f32_32x32x16_bf16(pa2, PK(l2, h2), od, 0, 0, 0);
  od = __builtin_amdgcn_mfma_f32_32x32x16_bf16(pa3, PK(l3, h3), od, 0, 0, 0);
#undef PK
}
__device__ __forceinline__ void pv_d0(f32x16* o, int vb, bf16x8 pa0, bf16x8 pa1, bf16x8 pa2, bf16x8 pa3) {
  pv_one<0>(o[0], vb, pa0, pa1, pa2, pa3); pv_one<1>(o[1], vb, pa0, pa1, pa2, pa3); pv_one<2>(o[2], vb, pa0, pa1, pa2, pa3); pv_one<3>(o[3], vb, pa0, pa1, pa2, pa3);
}
template <typename TQ>
__device__ __forceinline__ void attn_dense_body(const TQ* __restrict__ Qb, const bf16* __restrict__ Kh, const bf16* __restrict__ Vh,
                                                unsigned short* __restrict__ Ob, int seq, char* lds, int wv) {
  using St = Stage<bf16>; using SQ = Stage<TQ>;
  const int tid = ltid(wv), wid = tid >> 6, lane = tid & 63, r32 = lane & 31, hi = lane >> 5;
  bf16* V_lds = (bf16*)lds; bf16* K_lds = (bf16*)(lds + 2 * SHM_V);
  float* ws = (float*)(lds + 2 * SHM_V + 2 * SHM_K) + wid * 64; float* li_l = ws; float* al_l = ws + 32;
  float m_reg = -1e30f, l_reg = 0; f32x16 o[4] = {}; bf16x8 qr[8];
  const TQ* Qw = Qb + (long)(wid * QBLK + r32) * LDQ + hi * 8;
#pragma unroll
  for (int d0 = 0; d0 < 8; ++d0) qr[d0] = SQ::tobf(SQ::ld8(Qw + d0 * 16));
  const int sr = tid >> 4, sc = (tid & 15) * 8, vst0 = v_st(sr, sc), vst1 = v_st(32 + sr, sc);
  const int vb0 = (int)(uintptr_t)V_lds + v_rd_base(lane);
  struct { typename St::T vs0, vs1, ks0, ks1; } sr_[SDEPTH];
#define SLOAD(i, k0) do { sr_[i].vs0 = St::ld8(&Vh[(long)((k0) + sr) * LDK + sc]); sr_[i].vs1 = St::ld8(&Vh[(long)((k0) + 32 + sr) * LDK + sc]); \
    sr_[i].ks0 = St::ld8(&Kh[(long)((k0) + sr) * LDK + sc]); sr_[i].ks1 = St::ld8(&Kh[(long)((k0) + 32 + sr) * LDK + sc]); } while (0)
#define SWRITE(b, i) do { *(bf16x8*)((char*)V_lds + (b) * SHM_V + vst0) = St::tobf(sr_[i].vs0);          \
    *(bf16x8*)((char*)V_lds + (b) * SHM_V + vst1) = St::tobf(sr_[i].vs1); int kc = sc * 2;               \
    *(bf16x8*)((char*)K_lds + (b) * SHM_K + KSWZ(sr, kc)) = St::tobf(sr_[i].ks0);                       \
    *(bf16x8*)((char*)K_lds + (b) * SHM_K + KSWZ(32 + sr, kc)) = St::tobf(sr_[i].ks1); } while (0)
#define SWAIT() do { if constexpr (SDEPTH == 2) asm volatile("s_waitcnt vmcnt(4)" ::: "memory"); else asm volatile("s_waitcnt vmcnt(0)" ::: "memory"); } while (0)
#define RESC(a) do { if (__any((a) < 1.f)) { if (hi == 0) al_l[r32] = (a); asm volatile("s_waitcnt lgkmcnt(0)" ::: "memory"); \
    for (int d = 0; d < 4; ++d) for (int r = 0; r < 16; ++r) o[d][r] *= al_l[crow(r, hi)]; } } while (0)
  f32x16 pA0, pA1, pB0, pB1; float mnA, mnB, alA, alB; bf16x8 pa0, pa1, pa2, pa3; const int NT = seq / KVBLK;
  constexpr int SE = 0, SO = SDEPTH - 1;
  SLOAD(SE, 0); asm volatile("s_waitcnt vmcnt(0)" ::: "memory"); SWRITE(0, SE); __syncthreads();
  qkt(pA0, pA1, K_lds, qr, r32, hi); partialSM(pA0, pA1, m_reg, mnA, alA);
  SLOAD(SO, KVBLK); if constexpr (SDEPTH == 2) { if (2 < NT) SLOAD(SE, 2 * KVBLK); }
  SWAIT(); SWRITE(1, SO); __syncthreads();
  for (int j = 1; j + 1 < NT; j += 2) {
    SBAR(); qkt(pB0, pB1, (bf16*)((char*)K_lds + SHM_K), qr, r32, hi);
    finishSM(pA0, pA1, alA, l_reg, pa0, pa1, pa2, pa3); SBAR();
    SLOAD(SO, (j + SDEPTH) * KVBLK); SBAR();
    pv_d0(o, vb0, pa0, pa1, pa2, pa3); partialSM(pB0, pB1, m_reg, mnB, alB);
    __syncthreads(); SWAIT(); SWRITE(0, SE);
    RESC(alB); __syncthreads();
    SBAR(); qkt(pA0, pA1, K_lds, qr, r32, hi);
    finishSM(pB0, pB1, alB, l_reg, pa0, pa1, pa2, pa3); SBAR();
    if (SDEPTH == 1 || j + 3 < NT) SLOAD(SE, (j + 1 + SDEPTH) * KVBLK); SBAR();
    pv_d0(o, vb0 + (int)SHM_V, pa0, pa1, pa2, pa3); partialSM(pA0, pA1, m_reg, mnA, alA);
    __syncthreads(); SWAIT(); SWRITE(1, SO);
    RESC(alA); __syncthreads();
  }
  SBAR(); qkt(pB0, pB1, (bf16*)((char*)K_lds + SHM_K), qr, r32, hi);
  finishSM(pA0, pA1, alA, l_reg, pa0, pa1, pa2, pa3); SBAR();
  pv_d0(o, vb0, pa0, pa1, pa2, pa3); partialSM(pB0, pB1, m_reg, mnB, alB);
  __syncthreads(); RESC(alB);
  finishSM(pB0, pB1, alB, l_reg, pa0, pa1, pa2, pa3); SBAR();
  pv_d0(o, vb0 + (int)SHM_V, pa0, pa1, pa2, pa3);
  if (hi == 0) li_l[r32] = l_reg; asm volatile("s_waitcnt lgkmcnt(0)" ::: "memory");
  float rli[16];
#pragma unroll
  for (int r = 0; r < 16; ++r) rli[r] = __builtin_amdgcn_rcpf(li_l[crow(r, hi)]);
  unsigned short* Ow = Ob + (long)(wid * QBLK) * LDO;
#pragma unroll
  for (int r = 0; r < 16; ++r) { int orow = crow(r, hi);
    for (int d0 = 0; d0 < 4; ++d0) Ow[(long)orow * LDO + d0 * 32 + r32] = (unsigned short)(cvtpk(o[d0][r] * rli[r], 0.f) & 0xffffu); }
#undef SLOAD
#undef SWRITE
#undef SWAIT
#undef RESC
}
}

#define LAS __attribute__((address_space(3)))
typedef unsigned short u16;
typedef short bf16x8 __attribute__((ext_vector_type(8)));
typedef float f32x4 __attribute__((ext_vector_type(4)));
typedef float f32x16 __attribute__((ext_vector_type(16)));
typedef unsigned u32x4 __attribute__((ext_vector_type(4)));
typedef unsigned u32x2 __attribute__((ext_vector_type(2)));

constexpr int M = 12288, MP = 4096, DM = 1024, FF = 2816, NMOD = 9216;
constexpr size_t HM = 524288;
constexpr size_t WS_MOD = 0, WS_ROPE = 262144, WS_AB = 2 * HM, WS_GC = 6 * HM;
constexpr size_t WS_WIN11 = 8 * HM, WS_WOUT11 = 30 * HM, WS_WDNO = 41 * HM, WS_WDNIN = 45 * HM, WS_WIN10 = 62 * HM, WS_WOUT10 = 84 * HM;
constexpr size_t WS_WIN00 = 95 * HM, WS_WIN01 = 117 * HM, WS_WOUT00 = 139 * HM, WS_WOUT01 = 150 * HM, WS_WQKV = 161 * HM, WS_WO = 167 * HM;
constexpr size_t WS_XN = 171 * HM, WS_BIG = 219 * HM;
constexpr size_t WS_G = WS_BIG;
constexpr size_t WS_Q = WS_BIG, WS_O = WS_BIG + 48 * HM, WS_KB = WS_BIG + 96 * HM, WS_VB = WS_BIG + 110 * HM;
constexpr size_t WS_QKVR = WS_BIG, WS_Z = WS_BIG + 144 * HM, WS_U = WS_BIG + 192 * HM, WS_QN = WS_BIG + 288 * HM, WS_W = 62 * HM, WS_KN = 158 * HM;
constexpr size_t WS_OF = WS_BIG + 48 * HM, WS_OB = WS_BIG + 96 * HM, WS_O2 = WS_BIG;
constexpr size_t WS_END = WS_QN + 48 * HM;
constexpr int OUT_NK = 12582912, OUT_NV = 13631488, OUT_SF = 14680064, OUT_SB = 16777216;
constexpr int LDS_BYTES = 147456, LDS_RED = 131072, LDS_BARST = 147392;
constexpr size_t WS_CTL = 524288, CTL_BYTES = 131072;
constexpr size_t WS_XBUF = 786432;

struct Params { const float* in[30]; float* out; unsigned char* ws; };

__device__ __forceinline__ unsigned cvtpk(float lo, float hi) { return cvtpk_rne(lo, hi); }
__device__ __forceinline__ u16 f2bf(float f) { return (u16)(cvtpk(f, 0.f) & 0xffffu); }
__device__ __forceinline__ float bflo(unsigned w) { return __uint_as_float(w << 16); }
__device__ __forceinline__ float bfhi(unsigned w) { return __uint_as_float(w & 0xffff0000u); }
__device__ __forceinline__ float silu(float x) { return x * __builtin_amdgcn_rcpf(1.0f + __expf(-x)); }
__device__ __forceinline__ float wave_sum(float v) {
#pragma unroll
    for (int o = 1; o < 64; o <<= 1) v += __shfl_xor(v, o);
    return v;
}
__device__ __forceinline__ int crow(int r, int hi) { return (r & 3) + 8 * (r >> 2) + 4 * hi; }
template <int KSTEPS> __device__ __forceinline__ void mm_tile(f32x16& acc, const LAS char* A, int sA, const LAS char* Bt, int sB, int r32, int hi) {
    bf16x8 a[KSTEPS], b[KSTEPS];
#pragma unroll
    for (int ks = 0; ks < KSTEPS; ++ks) { a[ks] = *(const LAS bf16x8*)(A + r32 * sA + (ks * 16 + hi * 8) * 2); b[ks] = *(const LAS bf16x8*)(Bt + r32 * sB + (ks * 16 + hi * 8) * 2); }
#pragma unroll
    for (int ks = 0; ks < KSTEPS; ++ks) acc = __builtin_amdgcn_mfma_f32_32x32x16_bf16(a[ks], b[ks], acc, 0, 0, 0);
}

__device__ __forceinline__ int map_col(int mode, int r) {
    if (mode == 1) { const int pn = r >> 8, w = r & 255; return w < 128 ? pn * 128 + w : FF + pn * 128 + (w - 128); }
    if (mode == 2) { if (r < 1280) { const int b4 = (r >> 4) & 1, b5 = (r >> 5) & 1; return (r & ~48) | (b4 << 5) | (b5 << 4); } return r; }
    return r;
}
__device__ __forceinline__ void transpose_item(const float* W, int K, int Nsrc, u16* WT, int mode, LAS float* scr, int item, int nblk, int lane) {
    const int kb = item / nblk, nb = item % nblk, k0 = 64 * kb, n0 = 64 * nb;
    const int r = lane >> 4, cg = lane & 15, sc = map_col(mode, n0 + 4 * cg);
#pragma unroll 8
    for (int i = 0; i < 16; ++i) { const int kk = 4 * i + r; const f32x4 v = *(const f32x4*)(W + (size_t)(k0 + kk) * Nsrc + sc);
        LAS float* d = scr + kk * 65 + 4 * cg; d[0] = v[0]; d[1] = v[1]; d[2] = v[2]; d[3] = v[3]; }
    asm volatile("s_waitcnt lgkmcnt(0)" ::: "memory");
    const int c = lane & 7;
#pragma unroll
    for (int j = 0; j < 8; ++j) { const int n = (lane >> 3) + 8 * j; const LAS float* s = scr + (8 * c) * 65 + n;
        u32x4 o; o.x = cvtpk(s[0 * 65], s[1 * 65]); o.y = cvtpk(s[2 * 65], s[3 * 65]); o.z = cvtpk(s[4 * 65], s[5 * 65]); o.w = cvtpk(s[6 * 65], s[7 * 65]);
        *(u32x4*)(WT + (size_t)(n0 + n) * K + k0 + 8 * c) = o; }
    asm volatile("s_waitcnt lgkmcnt(0)" ::: "memory");
}
__device__ __forceinline__ int seg_items(int sgm) { return (sgm == 0 || sgm == 4 || sgm == 8 || sgm == 10) ? 1408 : (sgm == 1 || sgm == 5 || sgm == 9 || sgm == 11) ? 704 : sgm == 2 ? 384 : sgm == 6 ? 1024 : 256; }
__device__ __forceinline__ void seg_item(const Params& P, int sgm, int r, LAS float* scr, int lane) {
    unsigned char* ws = P.ws;
    switch (sgm) {
        case 0:  transpose_item(P.in[11], DM, 2 * FF, (u16*)(ws + WS_WIN00), 1, scr, r, 88, lane); break;
        case 1:  transpose_item(P.in[12], FF, DM, (u16*)(ws + WS_WOUT00), 0, scr, r, 16, lane); break;
        case 2:  transpose_item(P.in[14], DM, 1536, (u16*)(ws + WS_WQKV), 2, scr, r, 24, lane); break;
        case 3:  transpose_item(P.in[17], DM, DM, (u16*)(ws + WS_WO), 0, scr, r, 16, lane); break;
        case 4:  transpose_item(P.in[27], DM, 2 * FF, (u16*)(ws + WS_WIN01), 1, scr, r, 88, lane); break;
        case 5:  transpose_item(P.in[28], FF, DM, (u16*)(ws + WS_WOUT01), 0, scr, r, 16, lane); break;
        case 6:  transpose_item(P.in[18], DM, 4096, (u16*)(ws + WS_WDNIN), 0, scr, r, 64, lane); break;
        case 7:  transpose_item(P.in[25], DM, DM, (u16*)(ws + WS_WDNO), 0, scr, r, 16, lane); break;
        case 8:  transpose_item(P.in[11] + (size_t)DM * 2 * FF, DM, 2 * FF, (u16*)(ws + WS_WIN10), 1, scr, r, 88, lane); break;
        case 9:  transpose_item(P.in[12] + (size_t)FF * DM, FF, DM, (u16*)(ws + WS_WOUT10), 0, scr, r, 16, lane); break;
        case 10: transpose_item(P.in[27] + (size_t)DM * 2 * FF, DM, 2 * FF, (u16*)(ws + WS_WIN11), 1, scr, r, 88, lane); break;
        default: transpose_item(P.in[28] + (size_t)FF * DM, FF, DM, (u16*)(ws + WS_WOUT11), 0, scr, r, 16, lane); break;
    }
}
__device__ __forceinline__ void copy_items_range(const Params& P, LAS char* lds, int seg0, int it_lo, int it_hi, int worker, int nworkers, int lane, int wid) {
    LAS float* scr = (LAS float*)(lds + wid * 16640);
    for (int it = it_lo + worker; it < it_hi; it += nworkers) { int r = it, sgm = seg0;
        while (r >= seg_items(sgm)) { r -= seg_items(sgm); ++sgm; }
        seg_item(P, sgm, r, scr, lane); }
}
__device__ __forceinline__ void copy_items(const Params& P, LAS char* lds, int seg0, int seg1, int first_wg, int wv) {
    if ((int)blockIdx.x < first_wg) return;
    const int tid = ltid(wv), lane = tid & 63, wid = tid >> 6; int n = 0;
    for (int sgm = seg0; sgm < seg1; ++sgm) n += seg_items(sgm);
    copy_items_range(P, lds, seg0, 0, n, ((int)blockIdx.x - first_wg) * 8 + wid, ((int)gridDim.x - first_wg) * 8, lane, wid);
}
__device__ __forceinline__ void phase0(const Params& P, LAS char* lds, int wv) {
    const int tid = ltid(wv), lane = tid & 63, wid = tid >> 6, G = gridDim.x;
    unsigned char* ws = P.ws;
    if ((int)blockIdx.x < 144 || G < 144) {
      LAS float* sc = (LAS float*)lds;
      LAS float* red = (LAS float*)(lds + 16384);
      for (int i = tid; i < 3072; i += 512) { const int cnd = i >> 10, k = i & 1023; const float v = cnd == 0 ? P.in[7][k] : P.in[6][(cnd - 1) * 1024 + k]; sc[i] = silu(v); }
      __syncthreads();
      float* MOD = (float*)(ws + WS_MOD);
      for (int it = blockIdx.x; it < 144; it += G) {
          const int l = it / 72, cb = it % 72, cg = tid & 31, kp = tid >> 5;
          const float* W = P.in[8] + (size_t)l * DM * NMOD + cb * 128 + cg * 4;
          f32x4 a0 = {0.f, 0.f, 0.f, 0.f}, a1 = a0, a2 = a0;
#pragma unroll 16
          for (int k = kp * 64; k < kp * 64 + 64; ++k) { const f32x4 w = *(const f32x4*)(W + (size_t)k * NMOD); a0 += w * sc[k]; a1 += w * sc[1024 + k]; a2 += w * sc[2048 + k]; }
          LAS float* rp = red + (kp * 32 + cg) * 12;
#pragma unroll
          for (int j = 0; j < 4; ++j) { rp[j] = a0[j]; rp[4 + j] = a1[j]; rp[8 + j] = a2[j]; }
          __syncthreads();
          if (tid < 384) { const int c2 = tid & 127, cnd = tid >> 7; float s = P.in[9][l * NMOD + cb * 128 + c2];
#pragma unroll
              for (int q = 0; q < 16; ++q) s += red[(q * 32 + (c2 >> 2)) * 12 + cnd * 4 + (c2 & 3)];
              MOD[(l * 3 + cnd) * NMOD + cb * 128 + c2] = s; }
          __syncthreads();
      } }
    __syncthreads();
    {   const bool gemvwg = (int)blockIdx.x < 144 && G == 256;
        constexpr int NI = 1408 + 704, NSPLIT = NI;
        if (G == 256) { if (gemvwg) copy_items_range(P, lds, 0, NSPLIT, NI, (int)blockIdx.x * 8 + wid, 144 * 8, lane, wid); else copy_items_range(P, lds, 0, 0, NSPLIT, ((int)blockIdx.x - 144) * 8 + wid, 112 * 8, lane, wid); }
        else copy_items_range(P, lds, 0, 0, NI, (int)blockIdx.x * 8 + wid, G * 8, lane, wid);
    }
    { u16* WT = (u16*)(ws + WS_WDNIN); const float* wa = P.in[20]; const float* wb = P.in[23];
      for (int idx = blockIdx.x * 512 + tid; idx < 256 * 1024; idx += G * 512) {
          const int rr = idx >> 10, k = idx & 1023; float v = 0.f;
          if (rr < 16) v = wa[((rr >> 3) * 1024 + k) * 8 + (rr & 7)]; else if (rr < 32) v = wb[(((rr - 16) >> 3) * 1024 + k) * 8 + (rr & 7)];
          WT[(size_t)(4096 + rr) * 1024 + k] = f2bf(v); } }
    if (blockIdx.x == G - 1) { float* rope = (float*)(ws + WS_ROPE);
        for (int idx = tid; idx < 2048; idx += 512) { const int pos = idx >> 5, f = idx & 31;
            const float inv = exp2f(-(float)f * (13.287712379549449f / 32.0f)); const float ang = (float)pos * inv;
            rope[idx] = cosf(ang); rope[2048 + idx] = sinf(ang); } }
}

template <bool FIRST> __device__ __forceinline__ void normmod_phase(const Params& P, const float* gain, const float* modl, int ishift, int iscale, int wv) {
    const int lane = ltid(wv) & 63, gw = blockIdx.x * 8 + (ltid(wv) >> 6), NGW = gridDim.x * 8;
    u16* XN = (u16*)(P.ws + WS_XN); float* h = P.out;
    f32x4 gv[4];
#pragma unroll
    for (int j = 0; j < 4; ++j) gv[j] = *(const f32x4*)(gain + 4 * lane + 256 * j);
    for (int row = gw; row < M; row += NGW) {
        const float* src = FIRST ? (row < MP ? P.in[0] + (size_t)row * DM : P.in[1] + (size_t)(row - MP) * DM) : h + (size_t)row * DM;
        const int cond = row < MP ? 0 : (row < MP + 4096 ? 1 : 2);
        const float* sh = modl + cond * NMOD + ishift * 1024, * scl = modl + cond * NMOD + iscale * 1024;
        f32x4 v[4]; float s = 0.f;
#pragma unroll
        for (int j = 0; j < 4; ++j) { v[j] = *(const f32x4*)(src + 4 * lane + 256 * j); s += (v[j][0] * v[j][0] + v[j][1] * v[j][1]) + (v[j][2] * v[j][2] + v[j][3] * v[j][3]); }
        const float rinv = 1.0f / sqrtf(wave_sum(s) * (1.0f / DM) + 1e-6f);
#pragma unroll
        for (int j = 0; j < 4; ++j) {
            if (FIRST) *(f32x4*)(h + (size_t)row * DM + 4 * lane + 256 * j) = v[j];
            const f32x4 sv = *(const f32x4*)(sh + 4 * lane + 256 * j), cv = *(const f32x4*)(scl + 4 * lane + 256 * j);
            const f32x4 y = v[j] * rinv * gv[j] * (cv + 1.0f) + sv;
            u32x2 w; w.x = cvtpk(y[0], y[1]); w.y = cvtpk(y[2], y[3]);
            *(u32x2*)(XN + (size_t)row * DM + 4 * lane + 256 * j) = w;
        }
    }
}
__device__ __forceinline__ void final_norm_phase(const Params& P, int wv) {
    const int lane = ltid(wv) & 63, gw = blockIdx.x * 8 + (ltid(wv) >> 6), NGW = gridDim.x * 8;
    float* h = P.out; const float* gain = P.in[29];
    f32x4 gv[4];
#pragma unroll
    for (int j = 0; j < 4; ++j) gv[j] = *(const f32x4*)(gain + 4 * lane + 256 * j);
    for (int row = gw; row < M; row += NGW) {
        float* src = h + (size_t)row * DM; f32x4 v[4]; float s = 0.f;
#pragma unroll
        for (int j = 0; j < 4; ++j) { v[j] = *(const f32x4*)(src + 4 * lane + 256 * j); s += (v[j][0] * v[j][0] + v[j][1] * v[j][1]) + (v[j][2] * v[j][2] + v[j][3] * v[j][3]); }
        const float rinv = 1.0f / sqrtf(wave_sum(s) * (1.0f / DM) + 1e-6f);
#pragma unroll
        for (int j = 0; j < 4; ++j) *(f32x4*)(src + 4 * lane + 256 * j) = v[j] * rinv * gv[j];
    }
}
__device__ __forceinline__ void cache_copy(const Params& P, int wv) {
    u16* KB = (u16*)(P.ws + WS_KB); u16* VB = (u16*)(P.ws + WS_VB);
    for (int i = blockIdx.x * 512 + ltid(wv); i < 2 * 2 * 512 * 64; i += gridDim.x * 512) {
        const int which = i >> 16, j = i & 65535, b = j >> 15, rem = j & 32767;
        const f32x4 v = *(const f32x4*)(P.in[which ? 3 : 2] + (size_t)b * 131072 + rem * 4);
        u32x2 w; w.x = cvtpk(v[0], v[1]); w.y = cvtpk(v[2], v[3]);
        *(u32x2*)((which ? VB : KB) + (size_t)(4096 + b * 4608) * 256 + rem * 4) = w;
    }
}

__device__ __forceinline__ void attn_phase(const Params& P, char* lds, int wv) {
    const att::bf16* Q = (const att::bf16*)(P.ws + WS_Q); const att::bf16* KB = (const att::bf16*)(P.ws + WS_KB); const att::bf16* VB = (const att::bf16*)(P.ws + WS_VB);
    u16* O = (u16*)(P.ws + WS_O);
    for (int u = blockIdx.x; u < 384; u += gridDim.x) {
        size_t qrow, krow; int head, kvh, seq;
        if (u < 256) { const int x = u & 7, i = u >> 3, pair = x >> 1, b = pair >> 1, sub = (x & 1) * 32 + i, qb = sub & 15; kvh = pair & 1; head = kvh * 4 + (sub >> 4);
            qrow = 4096 + (size_t)b * 4096 + qb * 256; krow = 4096 + (size_t)b * 4608; seq = 4608; }
        else { const int v = u - 256, b = v >> 3; head = v & 7; kvh = head >> 2; qrow = (size_t)b * 256; krow = qrow; seq = 256; }
        att::attn_dense_body<att::bf16>(Q + qrow * 1024 + head * 128, KB + krow * 256 + kvh * 128, VB + krow * 256 + kvh * 128, O + qrow * 1024 + head * 128, seq, lds, wv);
        __syncthreads();
    }
}

__device__ __forceinline__ void ab_tile_phase(const Params& P, LAS char* lds, int wv) {
    const int tid = ltid(wv), lane = tid & 63, wid = tid >> 6, r32 = lane & 31, hi = lane >> 5;
    const u16* XN = (const u16*)(P.ws + WS_XN); const u16* WT = (const u16*)(P.ws + WS_WDNIN) + (size_t)4096 * 1024; float* AB = (float*)(P.ws + WS_AB);
    LAS float* red = (LAS float*)lds;
    for (int blk = blockIdx.x; blk < 192; blk += gridDim.x) {
        const int row0 = blk * 64;
        f32x16 acc0 = {}, acc1 = {};
        bf16x8 a0[8], a1[8], b[8];
#pragma unroll
        for (int ks = 0; ks < 8; ++ks) { const int k = (wid * 8 + ks) * 16 + hi * 8;
            b[ks] = *(const bf16x8*)(WT + (size_t)r32 * 1024 + k);
            a0[ks] = *(const bf16x8*)(XN + (size_t)(row0 + r32) * 1024 + k); a1[ks] = *(const bf16x8*)(XN + (size_t)(row0 + 32 + r32) * 1024 + k); }
#pragma unroll
        for (int ks = 0; ks < 8; ++ks) { acc0 = __builtin_amdgcn_mfma_f32_32x32x16_bf16(a0[ks], b[ks], acc0, 0, 0, 0); acc1 = __builtin_amdgcn_mfma_f32_32x32x16_bf16(a1[ks], b[ks], acc1, 0, 0, 0); }
#pragma unroll
        for (int r = 0; r < 16; ++r) { red[((wid * 2 + 0) * 16 + r) * 64 + lane] = acc0[r]; red[((wid * 2 + 1) * 16 + r) * 64 + lane] = acc1[r]; }
        __syncthreads();
        for (int o = tid; o < 2048; o += 512) { float s = 0.f;
#pragma unroll
            for (int w = 0; w < 8; ++w) s += red[w * 2048 + o];
            const int mt = o >> 10, r = (o >> 6) & 15, l = o & 63;
            AB[(size_t)(row0 + mt * 32 + crow(r, l >> 5)) * 32 + (l & 31)] = s; }
        __syncthreads();
    }
}

__device__ __forceinline__ void conv8(const u16* p, bool hasPrev, bool hasNext, const float* cw, float (&out)[8]) {
    const u32x4 z = {0u, 0u, 0u, 0u};
    const u32x4 xc = *(const u32x4*)p, xp = hasPrev ? *(const u32x4*)(p - 3072) : z, xn = hasNext ? *(const u32x4*)(p + 3072) : z;
    const f32x4 w0a = *(const f32x4*)cw, w0b = *(const f32x4*)(cw + 4), w1a = *(const f32x4*)(cw + 3072), w1b = *(const f32x4*)(cw + 3076), w2a = *(const f32x4*)(cw + 6144), w2b = *(const f32x4*)(cw + 6148);
#pragma unroll
    for (int i = 0; i < 4; ++i) {
        const float w0l = i < 2 ? w0a[2 * i] : w0b[2 * i - 4], w0h = i < 2 ? w0a[2 * i + 1] : w0b[2 * i - 3];
        const float w1l = i < 2 ? w1a[2 * i] : w1b[2 * i - 4], w1h = i < 2 ? w1a[2 * i + 1] : w1b[2 * i - 3];
        const float w2l = i < 2 ? w2a[2 * i] : w2b[2 * i - 4], w2h = i < 2 ? w2a[2 * i + 1] : w2b[2 * i - 3];
        out[2 * i] = silu(bflo(xp[i]) * w0l + bflo(xc[i]) * w1l + bflo(xn[i]) * w2l);
        out[2 * i + 1] = silu(bfhi(xp[i]) * w0h + bfhi(xc[i]) * w1h + bfhi(xn[i]) * w2h);
    }
}
constexpr int D1_K = 0, D1_KT = 17408, D1_VT = 35840, D1_A0 = 54272, D1_A1 = 71680, D1_T = 89088, D1_GC = 125952;
__device__ __forceinline__ void d1_task(const Params& P, int ch, int h, LAS char* lds, int wv) {
    const int tid = ltid(wv), lane = tid & 63, wid = tid >> 6, r32 = lane & 31, hi = lane >> 5;
    unsigned char* ws = P.ws;
    const u16* QKVR = (const u16*)(ws + WS_QKVR); const float* AB = (const float*)(ws + WS_AB); float* GC = (float*)(ws + WS_GC);
    u16* QN = (u16*)(ws + WS_QN); u16* KN = (u16*)(ws + WS_KN); u16* U = (u16*)(ws + WS_U); u16* W = (u16*)(ws + WS_W);
    LAS char* Kl = lds + D1_K; LAS char* KTl = lds + D1_KT; LAS char* VTl = lds + D1_VT;
    LAS float* A0f = (LAS float*)(lds + D1_A0); LAS float* A1f = (LAS float*)(lds + D1_A1); LAS char* Tl = lds + D1_T;
    LAS float* gcl = (LAS float*)(lds + D1_GC); LAS float* betal = gcl + 128;
    const int r0 = ch * 64, seqlen = r0 < MP ? 256 : 4096;
    float ab_a = 0.f, ab_b = 0.f, dtb = 0.f, alg = 0.f;
    if (wid < 2) { const int row = r0 + lane; ab_a = AB[(size_t)row * 32 + wid * 8 + h]; ab_b = AB[(size_t)row * 32 + 16 + wid * 8 + h]; dtb = P.in[21][wid * 8 + h]; alg = P.in[22][wid * 8 + h]; }
    {
        const int c = tid >> 3, grp = tid & 7, row = r0 + c;
        const bool hasPrev = (row % seqlen) != 0, hasNext = ((row + 1) % seqlen) != 0;
        const u16* p = QKVR + (size_t)row * 3072 + h * 128 + grp * 16; const float* cw = P.in[19] + h * 128 + grp * 16;
        float qa[8], qb[8], ka[8], kb[8], va[8], vb[8];
        conv8(p, hasPrev, hasNext, cw, qa); conv8(p + 8, hasPrev, hasNext, cw + 8, qb);
        conv8(p + 1024, hasPrev, hasNext, cw + 1024, ka); conv8(p + 1032, hasPrev, hasNext, cw + 1032, kb);
        conv8(p + 2048, hasPrev, hasNext, cw + 2048, va); conv8(p + 2056, hasPrev, hasNext, cw + 2056, vb);
        float sq = 0.f, sk = 0.f;
#pragma unroll
        for (int i = 0; i < 8; ++i) { sq += qa[i] * qa[i] + qb[i] * qb[i]; sk += ka[i] * ka[i] + kb[i] * kb[i]; }
        sq += __shfl_xor(sq, 1); sq += __shfl_xor(sq, 2); sq += __shfl_xor(sq, 4);
        sk += __shfl_xor(sk, 1); sk += __shfl_xor(sk, 2); sk += __shfl_xor(sk, 4);
        const float rq = 0.088388347648318440f / sqrtf(sq + 1e-6f), rk = 1.0f / sqrtf(sk + 1e-6f);
        u32x4 q0, q1, w0, w1;
        q0.x = cvtpk(qa[0] * rq, qa[1] * rq); q0.y = cvtpk(qa[2] * rq, qa[3] * rq); q0.z = cvtpk(qa[4] * rq, qa[5] * rq); q0.w = cvtpk(qa[6] * rq, qa[7] * rq);
        q1.x = cvtpk(qb[0] * rq, qb[1] * rq); q1.y = cvtpk(qb[2] * rq, qb[3] * rq); q1.z = cvtpk(qb[4] * rq, qb[5] * rq); q1.w = cvtpk(qb[6] * rq, qb[7] * rq);
        w0.x = cvtpk(ka[0] * rk, ka[1] * rk); w0.y = cvtpk(ka[2] * rk, ka[3] * rk); w0.z = cvtpk(ka[4] * rk, ka[5] * rk); w0.w = cvtpk(ka[6] * rk, ka[7] * rk);
        w1.x = cvtpk(kb[0] * rk, kb[1] * rk); w1.y = cvtpk(kb[2] * rk, kb[3] * rk); w1.z = cvtpk(kb[4] * rk, kb[5] * rk); w1.w = cvtpk(kb[6] * rk, kb[7] * rk);
        { u16* dst = QN + (size_t)row * 1024 + h * 128 + grp * 16; *(u32x4*)dst = q0; *(u32x4*)(dst + 8) = q1; }
        { u16* dst = KN + (size_t)row * 1024 + h * 128 + grp * 16; *(u32x4*)dst = w0; *(u32x4*)(dst + 8) = w1; }
        *(LAS u32x4*)(Kl + c * 272 + grp * 32) = w0; *(LAS u32x4*)(Kl + c * 272 + grp * 32 + 16) = w1;
#pragma unroll
        for (int i = 0; i < 4; ++i) {
            *(LAS u16*)(KTl + (grp * 16 + 2 * i) * 144 + c * 2) = (u16)(w0[i] & 0xffffu); *(LAS u16*)(KTl + (grp * 16 + 2 * i + 1) * 144 + c * 2) = (u16)(w0[i] >> 16);
            *(LAS u16*)(KTl + (grp * 16 + 8 + 2 * i) * 144 + c * 2) = (u16)(w1[i] & 0xffffu); *(LAS u16*)(KTl + (grp * 16 + 9 + 2 * i) * 144 + c * 2) = (u16)(w1[i] >> 16); }
#pragma unroll
        for (int i = 0; i < 8; ++i) { *(LAS u16*)(VTl + (grp * 16 + i) * 144 + c * 2) = f2bf(va[i]); *(LAS u16*)(VTl + (grp * 16 + 8 + i) * 144 + c * 2) = f2bf(vb[i]); }
    }
    if (wid < 2) {
        const int dir = wid, c = lane, row = r0 + c;
        const float av = ab_a + dtb;
        const float sp = av > 20.f ? av : log1pf(expf(av));
        const float g = -expf(alg) * sp;
        const float bt = 1.0f / (1.0f + expf(-ab_b));
        float s = g;
#pragma unroll
        for (int off = 1; off < 64; off <<= 1) {
            const float t = dir == 0 ? __shfl_up(s, off) : __shfl_down(s, off);
            const bool ok = dir == 0 ? (lane >= off) : (lane + off < 64);
            if (ok) s += t;
        }
        gcl[dir * 64 + c] = s; betal[dir * 64 + c] = bt; GC[((size_t)dir * M + row) * 8 + h] = s;
    }
    __syncthreads();
    if (wid < 4) {
        const int mt = wid >> 1, nt = wid & 1; f32x16 acc = {};
        mm_tile<8>(acc, Kl + mt * 32 * 272, 272, Kl + nt * 32 * 272, 272, r32, hi);
        const int s = nt * 32 + r32; const float gs0 = gcl[s], gs1 = gcl[64 + s]; float g0v[16], g1v[16], b0v[16], b1v[16];
#pragma unroll
        for (int r = 0; r < 16; ++r) { const int c = mt * 32 + crow(r, hi); g0v[r] = gcl[c]; g1v[r] = gcl[64 + c]; b0v[r] = betal[c]; b1v[r] = betal[64 + c]; }
#pragma unroll
        for (int r = 0; r < 16; ++r) { const int c = mt * 32 + crow(r, hi); const float kk = acc[r];
            const float a0 = (c > s) ? b0v[r] * kk * __expf(fminf(g0v[r] - gs0, 0.f)) : 0.f;
            const float a1 = (c < s) ? b1v[r] * kk * __expf(fminf(g1v[r] - gs1, 0.f)) : 0.f;
            A0f[c * 68 + s] = a0; A1f[(63 - c) * 68 + (63 - s)] = a1; }
    }
    __syncthreads();
    if (wid < 2) {
        const int dir = wid, j = lane; LAS float* Af = dir ? A1f : A0f;
        for (int ib = 0; ib < 8; ++ib) {
            float s[8];
#pragma unroll
            for (int r = 0; r < 8; ++r) s[r] = (8 * ib + r == j) ? 1.f : 0.f;
#pragma unroll 2
            for (int m2 = 0; m2 < 8 * ib; m2 += 4) {
                const float x0 = Af[(m2 + 0) * 68 + j], x1 = Af[(m2 + 1) * 68 + j], x2 = Af[(m2 + 2) * 68 + j], x3 = Af[(m2 + 3) * 68 + j];
#pragma unroll
                for (int r = 0; r < 8; ++r) { const f32x4 a = *(const LAS f32x4*)(Af + (8 * ib + r) * 68 + m2); s[r] -= (a[0] * x0 + a[1] * x1) + (a[2] * x2 + a[3] * x3); }
            }
            f32x4 dl[8], dh[8];
#pragma unroll
            for (int r = 0; r < 8; ++r) { dl[r] = *(const LAS f32x4*)(Af + (8 * ib + r) * 68 + 8 * ib); dh[r] = *(const LAS f32x4*)(Af + (8 * ib + r) * 68 + 8 * ib + 4); }
#pragma unroll
            for (int r = 1; r < 8; ++r) {
#pragma unroll
                for (int q = 0; q < r; ++q) s[r] -= (q < 4 ? dl[r][q] : dh[r][q - 4]) * s[q];
            }
            asm volatile("s_waitcnt lgkmcnt(0)" ::: "memory");
#pragma unroll
            for (int r = 0; r < 8; ++r) Af[(8 * ib + r) * 68 + j] = s[r];
        }
    }
    __syncthreads();
    {
#pragma unroll 4
        for (int k = 0; k < 16; ++k) { const int idx = tid + 512 * k, dir = idx >> 12, c = (idx >> 6) & 63, s = idx & 63;
            const float t = dir ? A1f[(63 - c) * 68 + (63 - s)] : A0f[c * 68 + s];
            const float bs = betal[dir * 64 + s], bgs = bs * __expf(gcl[dir * 64 + s]);
            *(LAS u16*)(Tl + (dir * 2) * 9216 + c * 144 + s * 2) = f2bf(t * bs); *(LAS u16*)(Tl + (dir * 2 + 1) * 9216 + c * 144 + s * 2) = f2bf(t * bgs); }
    }
    __syncthreads();
    {
        const int dir = wid >> 2, kind = (wid >> 1) & 1, tbase = (wid & 1) * 4;
        const LAS char* Aop = kind ? KTl : VTl; const LAS char* Bop = Tl + (dir * 2 + kind) * 9216;
        const size_t tb = ((size_t)dir * 192 + ch) * 8 + h;
#pragma unroll
        for (int t = 0; t < 4; ++t) { const int tile = tbase + t, mt = tile >> 1, nt = tile & 1; f32x16 acc = {};
            mm_tile<4>(acc, Aop + mt * 32 * 144, 144, Bop + nt * 32 * 144, 144, r32, hi);
            if (kind == 0) { u16* dst = U + ((tb * 8 + tile) * 64 + lane) * 16; u32x4 w0, w1;
                w0.x = cvtpk(acc[0], acc[1]); w0.y = cvtpk(acc[2], acc[3]); w0.z = cvtpk(acc[4], acc[5]); w0.w = cvtpk(acc[6], acc[7]);
                w1.x = cvtpk(acc[8], acc[9]); w1.y = cvtpk(acc[10], acc[11]); w1.z = cvtpk(acc[12], acc[13]); w1.w = cvtpk(acc[14], acc[15]);
                *(u32x4*)dst = w0; *(u32x4*)(dst + 8) = w1; }
            else { const int c = nt * 32 + r32; u16* dst = W + (tb * 64 + c) * 128 + mt * 32 + 4 * hi;
#pragma unroll
                for (int q = 0; q < 4; ++q) { u32x2 w; w.x = cvtpk(acc[4 * q], acc[4 * q + 1]); w.y = cvtpk(acc[4 * q + 2], acc[4 * q + 3]); *(u32x2*)(dst + 8 * q) = w; } }
        }
    }
    __syncthreads();
}

constexpr int D2_ST = 0, D2_W = 17408, D2_Q = 34816, D2_K = 52224, D2_KT = 69632, D2_VN = 88064, D2_VN2 = 97280, D2_QK = 106496, D2_GC = 115712, D2_KT2OFF = 116224 - 69632;
__device__ __forceinline__ void d2_chain(const Params& P, int seq, int h, int dir, int vh, LAS char* lds, int wv) {
    const int tid = ltid(wv), lane = tid & 63, wid = tid >> 6, r32 = lane & 31, hi = lane >> 5;
    unsigned char* ws = P.ws;
    const u16* QN = (const u16*)(ws + WS_QN); const u16* KN = (const u16*)(ws + WS_KN); const u16* U = (const u16*)(ws + WS_U); const u16* W = (const u16*)(ws + WS_W);
    const float* GC = (const float*)(ws + WS_GC); u16* OX = (u16*)(ws + (dir ? WS_OB : WS_OF));
    LAS char* STl = lds + D2_ST; LAS char* Wl = lds + D2_W; LAS char* Ql = lds + D2_Q; LAS char* Kl = lds + D2_K; LAS char* KTl = lds + D2_KT;
    LAS char* VNl = lds + D2_VN; LAS char* VN2l = lds + D2_VN2; LAS char* QKl = lds + D2_QK; LAS float* gcl = (LAS float*)(lds + D2_GC);
    const bool samp = seq >= 16; const int rbase = samp ? MP + (seq - 16) * 4096 : seq * 256, nch = samp ? 64 : 4, ch0 = rbase >> 6;
    const int mtS = wid >> 2, ntS = wid & 3;
    const int mtl = (wid >> 1) & 1, ntc = wid & 1;
    f32x16 accS = {};
    if (samp) { const float* st = P.in[dir ? 5 : 4] + ((size_t)((seq - 16) * 8 + h) * 128) * 128 + (size_t)(ntS * 32 + r32) * 128 + vh * 64 + mtS * 32 + 4 * hi;
#pragma unroll
        for (int q = 0; q < 4; ++q) { const f32x4 t = *(const f32x4*)(st + 8 * q); accS[4 * q] = t[0]; accS[4 * q + 1] = t[1]; accS[4 * q + 2] = t[2]; accS[4 * q + 3] = t[3]; } }
    const int sc = tid >> 3, sg = tid & 7;
    u32x4 pq0, pq1, pk0, pk1, pw0, pw1, pu0 = {}, pu1 = {}; float pgc = 0.f;
#define D2_LOAD(n_) do { const int ch_ = ch0 + (dir ? nch - 1 - (n_) : (n_)); const size_t row_ = (size_t)ch_ * 64 + sc; \
        const u16* qp_ = QN + row_ * 1024 + h * 128 + sg * 16; pq0 = *(const u32x4*)qp_; pq1 = *(const u32x4*)(qp_ + 8); \
        const u16* kp_ = KN + row_ * 1024 + h * 128 + sg * 16; pk0 = *(const u32x4*)kp_; pk1 = *(const u32x4*)(kp_ + 8); \
        const size_t tb_ = ((size_t)dir * 192 + ch_) * 8 + h; \
        const u16* wp_ = W + (tb_ * 64 + sc) * 128 + sg * 16; pw0 = *(const u32x4*)wp_; pw1 = *(const u32x4*)(wp_ + 8); \
        if (wid < 4) { const u16* up_ = U + ((tb_ * 8 + (vh * 2 + mtl) * 2 + ntc) * 64 + lane) * 16; pu0 = *(const u32x4*)up_; pu1 = *(const u32x4*)(up_ + 8); } \
        if (tid < 64) pgc = GC[((size_t)dir * M + (size_t)ch_ * 64 + tid) * 8 + h]; } while (0)
    D2_LOAD(0);
    u32x4 u0, u1;
#define D2_STAGE_A() do { _Pragma("unroll") for (int r = 0; r < 16; ++r) *(LAS u16*)(STl + (mtS * 32 + crow(r, hi)) * 272 + (ntS * 32 + r32) * 2) = f2bf(accS[r]); \
        *(LAS u32x4*)(Ql + sc * 272 + sg * 32) = pq0; *(LAS u32x4*)(Ql + sc * 272 + sg * 32 + 16) = pq1; \
        *(LAS u32x4*)(Kl + sc * 272 + sg * 32) = pk0; *(LAS u32x4*)(Kl + sc * 272 + sg * 32 + 16) = pk1; \
        *(LAS u32x4*)(Wl + sc * 272 + sg * 32) = pw0; *(LAS u32x4*)(Wl + sc * 272 + sg * 32 + 16) = pw1; } while (0)
#define D2_STAGE_B(KT_, GC_) do { _Pragma("unroll") for (int i = 0; i < 4; ++i) { \
            *(LAS u16*)((KT_) + (sg * 16 + 2 * i) * 144 + sc * 2) = (u16)(pk0[i] & 0xffffu); *(LAS u16*)((KT_) + (sg * 16 + 2 * i + 1) * 144 + sc * 2) = (u16)(pk0[i] >> 16); \
            *(LAS u16*)((KT_) + (sg * 16 + 8 + 2 * i) * 144 + sc * 2) = (u16)(pk1[i] & 0xffffu); *(LAS u16*)((KT_) + (sg * 16 + 9 + 2 * i) * 144 + sc * 2) = (u16)(pk1[i] >> 16); } \
        if (tid < 64) (GC_)[tid] = pgc; u0 = pu0; u1 = pu1; } while (0)
    D2_STAGE_A(); D2_STAGE_B(KTl, gcl);
    __syncthreads();
    for (int n = 0; n < nch; ++n) {
        const int ch = ch0 + (dir ? nch - 1 - n : n);
        LAS char* KTc = KTl + (n & 1) * D2_KT2OFF; LAS char* KTn = KTl + ((n + 1) & 1) * D2_KT2OFF;
        LAS float* gcc = gcl + (n & 1) * 64; LAS float* gcn = gcl + ((n + 1) & 1) * 64;
        if (n + 1 < nch) D2_LOAD(n + 1);
        const float glast = gcc[dir ? 0 : 63];
        f32x16 acco = {};
        if (wid >= 4) {
            f32x16 acc = {}; mm_tile<8>(acc, Ql + mtl * 32 * 272, 272, Kl + ntc * 32 * 272, 272, r32, hi);
            const int s = ntc * 32 + r32; const float gs = gcc[s]; float gcv[16];
#pragma unroll
            for (int r = 0; r < 16; ++r) gcv[r] = gcc[mtl * 32 + crow(r, hi)];
#pragma unroll
            for (int r = 0; r < 16; ++r) { const int c = mtl * 32 + crow(r, hi); const bool valid = dir ? (c <= s) : (c >= s);
                const float val = valid ? acc[r] * __expf(fminf(gcv[r] - gs, 0.f)) : 0.f; *(LAS u16*)(QKl + c * 144 + s * 2) = f2bf(val); }
        } else {
            f32x16 acc = {}; mm_tile<8>(acc, STl + mtl * 32 * 272, 272, Wl + ntc * 32 * 272, 272, r32, hi);
            const int c = ntc * 32 + r32; const float e2 = __expf(glast - gcc[c]);
#pragma unroll
            for (int r = 0; r < 16; ++r) { const unsigned uw = r < 8 ? u0[r >> 1] : u1[(r - 8) >> 1]; const float uv = (r & 1) ? bfhi(uw) : bflo(uw);
                const float vn = uv - acc[r]; const int v = mtl * 32 + crow(r, hi);
                *(LAS u16*)(VNl + v * 144 + c * 2) = f2bf(vn); *(LAS u16*)(VN2l + v * 144 + c * 2) = f2bf(vn * e2); }
            mm_tile<8>(acco, STl + mtl * 32 * 272, 272, Ql + ntc * 32 * 272, 272, r32, hi);
            const float eg = __expf(gcc[c]);
#pragma unroll
            for (int r = 0; r < 16; ++r) acco[r] *= eg;
        }
        __syncthreads();
        if (wid < 4) {
            f32x16 acc = acco; const int c = ntc * 32 + r32;
            mm_tile<4>(acc, VNl + mtl * 32 * 144, 144, QKl + ntc * 32 * 144, 144, r32, hi);
            u16* dst = OX + ((size_t)ch * 64 + c) * 1024 + h * 128 + vh * 64 + mtl * 32 + 4 * hi;
#pragma unroll
            for (int q = 0; q < 4; ++q) { u32x2 w; w.x = cvtpk(acc[4 * q], acc[4 * q + 1]); w.y = cvtpk(acc[4 * q + 2], acc[4 * q + 3]); *(u32x2*)(dst + 8 * q) = w; }
        }
        {
            const float gl = __expf(glast);
#pragma unroll
            for (int r = 0; r < 16; ++r) accS[r] *= gl;
            mm_tile<4>(accS, VN2l + mtS * 32 * 144, 144, KTc + ntS * 32 * 144, 144, r32, hi);
        }
        if (n + 1 < nch) { D2_STAGE_A(); D2_STAGE_B(KTn, gcn); }
        __syncthreads();
    }
#undef D2_STAGE_A
#undef D2_STAGE_B
#undef D2_LOAD
    if (!samp) { float* dst = P.out + (dir ? OUT_SB : OUT_SF) + ((size_t)(seq * 8 + h) * 128 + ntS * 32 + r32) * 128 + vh * 64 + mtS * 32 + 4 * hi;
#pragma unroll
        for (int q = 0; q < 4; ++q) { f32x4 t; t[0] = accS[4 * q]; t[1] = accS[4 * q + 1]; t[2] = accS[4 * q + 2]; t[3] = accS[4 * q + 3]; *(f32x4*)(dst + 8 * q) = t; } }
}
__device__ __forceinline__ void d3_phase(const Params& P, int wv) {
    const int lane = ltid(wv) & 63, gw = blockIdx.x * 8 + (ltid(wv) >> 6), NGW = gridDim.x * 8;
    const u16* OF = (const u16*)(P.ws + WS_OF); const u16* OB = (const u16*)(P.ws + WS_OB); const u16* Z = (const u16*)(P.ws + WS_Z); u16* O2 = (u16*)(P.ws + WS_O2);
    const float* og = P.in[24] + (lane & 7) * 16;
    for (int row = gw; row < M; row += NGW) {
        const size_t off = (size_t)row * 1024 + lane * 16;
        const u32x4 a0 = *(const u32x4*)(OF + off), a1 = *(const u32x4*)(OF + off + 8), b0 = *(const u32x4*)(OB + off), b1 = *(const u32x4*)(OB + off + 8);
        const u32x4 z0 = *(const u32x4*)(Z + off), z1 = *(const u32x4*)(Z + off + 8);
        float v[16]; float s = 0.f;
#pragma unroll
        for (int i = 0; i < 4; ++i) { v[2 * i] = bflo(a0[i]) + bflo(b0[i]); v[2 * i + 1] = bfhi(a0[i]) + bfhi(b0[i]); v[8 + 2 * i] = bflo(a1[i]) + bflo(b1[i]); v[9 + 2 * i] = bfhi(a1[i]) + bfhi(b1[i]); }
#pragma unroll
        for (int i = 0; i < 16; ++i) s += v[i] * v[i];
        s += __shfl_xor(s, 1); s += __shfl_xor(s, 2); s += __shfl_xor(s, 4);
        const float rinv = 1.0f / sqrtf(s * (1.0f / 128.0f) + 1e-6f);
        u32x4 w0, w1;
#pragma unroll
        for (int i = 0; i < 4; ++i) {
            const float y0 = v[2 * i] * rinv * og[2 * i] * silu(bflo(z0[i])), y1 = v[2 * i + 1] * rinv * og[2 * i + 1] * silu(bfhi(z0[i]));
            const float y2 = v[8 + 2 * i] * rinv * og[8 + 2 * i] * silu(bflo(z1[i])), y3 = v[9 + 2 * i] * rinv * og[9 + 2 * i] * silu(bfhi(z1[i]));
            w0[i] = cvtpk(y0, y1); w1[i] = cvtpk(y2, y3); }
        *(u32x4*)(O2 + off) = w0; *(u32x4*)(O2 + off + 8) = w1;
    }
}

#define XB_TMO      128
#define XB_XCNT(j)  (256  + 64 * (j))
#define XB_XSUB(j)  (1280 + 64 * (j))
#define XB_XGEN(j)  (2304 + 64 * (j))
#define XB_TOP      3328
#define XB_TOPGEN   3392
#define XCD_BAR_WORDS 3456
#define XB_SPIN_CAP (1u << 18)

__device__ __forceinline__ unsigned xb_ld(unsigned* p)              { return __hip_atomic_load(p, __ATOMIC_RELAXED, __HIP_MEMORY_SCOPE_AGENT); }
__device__ __forceinline__ unsigned xb_add(unsigned* p, unsigned v) { return __hip_atomic_fetch_add(p, v, __ATOMIC_RELAXED, __HIP_MEMORY_SCOPE_AGENT); }
__device__ __forceinline__ unsigned xb_xcc_id() { return (unsigned)__builtin_amdgcn_s_getreg((3 << 11) | 20) & 0xFu; }
#define XB_SPIN(cond, bar) do { unsigned _sp = 0; while (cond) { __builtin_amdgcn_s_sleep(1); \
    if ((++_sp & 255u) == 0u) { if (xb_ld(&(bar)[XB_TMO])) break; if (_sp > XB_SPIN_CAP) { atomicAdd(&(bar)[XB_TMO], 1u); break; } } } } while (0)

struct XcdBarrier {
    unsigned* bar; unsigned x;
    volatile LAS unsigned* st;
};

__device__ __forceinline__ XcdBarrier xcd_barrier_post(unsigned* bar, volatile LAS unsigned* st) {
    XcdBarrier b; b.bar = bar; b.x = xb_xcc_id(); b.st = st;
    if (threadIdx.x == 0) (void)xb_add(&bar[XB_XCNT(b.x)], 1u);
    return b;
}
__device__ __forceinline__ void xcd_barrier_complete(unsigned* bar, unsigned x, unsigned& nloc, unsigned& nx) {
    const unsigned G = gridDim.x * gridDim.y * gridDim.z;
    unsigned sum, cnt, mine, sp = 0u;
    for (;;) {
        sum = 0u; cnt = 0u; mine = 0u;
#pragma unroll
        for (unsigned j = 0; j < 16; ++j) { const unsigned c = xb_ld(&bar[XB_XCNT(j)]); sum += c; cnt += (c > 0u) ? 1u : 0u; mine = (j == x) ? c : mine; }
        if (sum == G) break;
        __builtin_amdgcn_s_sleep(1);
        if ((++sp & 255u) == 0u) { if (xb_ld(&bar[XB_TMO])) break; if (sp > XB_SPIN_CAP) { atomicAdd(&bar[XB_TMO], 1u); break; } }
    }
    nloc = mine > 0u ? mine : 1u; nx = cnt > 0u ? cnt : 1u;
}

__device__ __forceinline__ void xcd_barrier(const XcdBarrier& b) {
    asm volatile("s_waitcnt vmcnt(0)" ::: "memory");
    __syncthreads();
    if (threadIdx.x == 0) {
        unsigned* bar = b.bar;
        __builtin_amdgcn_s_waitcnt(0);
        unsigned nloc = b.st[0], nx = b.st[1];
        if (nloc == 0u) { xcd_barrier_complete(bar, b.x, nloc, nx); b.st[0] = nloc; b.st[1] = nx; }
        const unsigned old = xb_add(&bar[XB_XSUB(b.x)], 1u);
        const unsigned gen = old / nloc;
        if (old + 1u == (gen + 1u) * nloc) {
            __builtin_amdgcn_fence(__ATOMIC_RELEASE, "agent");
            asm volatile("s_waitcnt vmcnt(0)" ::: "memory");
            const unsigned og = xb_add(&bar[XB_TOP], 1u);
            const unsigned tg = og / nx;
            if (og + 1u == (tg + 1u) * nx) xb_add(&bar[XB_TOPGEN], 1u);
            else XB_SPIN(xb_ld(&bar[XB_TOPGEN]) == tg, bar);
            __builtin_amdgcn_fence(__ATOMIC_ACQUIRE, "agent");
            xb_add(&bar[XB_XGEN(b.x)], 1u);
            asm volatile("s_waitcnt vmcnt(0)" ::: "memory");
        } else {
            XB_SPIN(xb_ld(&bar[XB_XGEN(b.x)]) == gen, bar);
            __builtin_amdgcn_fence(__ATOMIC_ACQUIRE, "agent");
            asm volatile("s_waitcnt vmcnt(0)" ::: "memory");
        }
    }
    __syncthreads();
}

__device__ __forceinline__ void xcd_barrier_complete_n(unsigned* bar, unsigned x, unsigned& nloc, unsigned& nx, unsigned NG) {
    unsigned sum, cnt, mine, sp = 0u;
    for (;;) {
        sum = 0u; cnt = 0u; mine = 0u;
#pragma unroll
        for (unsigned j = 0; j < 16; ++j) { const unsigned c = xb_ld(&bar[XB_XCNT(j)]); sum += c; cnt += (c > 0u) ? 1u : 0u; mine = (j == x) ? c : mine; }
        if (sum == NG) break;
        __builtin_amdgcn_s_sleep(1);
        if ((++sp & 255u) == 0u) { if (xb_ld(&bar[XB_TMO])) break; if (sp > XB_SPIN_CAP) { atomicAdd(&bar[XB_TMO], 1u); break; } }
    }
    nloc = mine > 0u ? mine : 1u; nx = cnt > 0u ? cnt : 1u;
}
__device__ __forceinline__ void xcd_barrier_n(const XcdBarrier& b, unsigned NG) {
    asm volatile("s_waitcnt vmcnt(0)" ::: "memory");
    __syncthreads();
    if (threadIdx.x == 0) {
        unsigned* bar = b.bar;
        __builtin_amdgcn_s_waitcnt(0);
        unsigned nloc = b.st[0], nx = b.st[1];
        if (nloc == 0u) { xcd_barrier_complete_n(bar, b.x, nloc, nx, NG); b.st[0] = nloc; b.st[1] = nx; }
        const unsigned old = xb_add(&bar[XB_XSUB(b.x)], 1u);
        const unsigned gen = old / nloc;
        if (old + 1u == (gen + 1u) * nloc) {
            __builtin_amdgcn_fence(__ATOMIC_RELEASE, "agent");
            asm volatile("s_waitcnt vmcnt(0)" ::: "memory");
            const unsigned og = xb_add(&bar[XB_TOP], 1u);
            const unsigned tg = og / nx;
            if (og + 1u == (tg + 1u) * nx) xb_add(&bar[XB_TOPGEN], 1u);
            else XB_SPIN(xb_ld(&bar[XB_TOPGEN]) == tg, bar);
            __builtin_amdgcn_fence(__ATOMIC_ACQUIRE, "agent");
            xb_add(&bar[XB_XGEN(b.x)], 1u);
            asm volatile("s_waitcnt vmcnt(0)" ::: "memory");
        } else {
            XB_SPIN(xb_ld(&bar[XB_XGEN(b.x)]) == gen, bar);
            __builtin_amdgcn_fence(__ATOMIC_ACQUIRE, "agent");
            asm volatile("s_waitcnt vmcnt(0)" ::: "memory");
        }
    }
    __syncthreads();
}

template <class Epi> __device__ __forceinline__ void run_gemm(LAS char* lds, const u16* A, const u16* Bt, int N, int K, const Epi& E, int wv) {
    pg8::Gemm g{A, Bt, M, N, K}; pg8::StaticOrder S; S.init(M, N, (int)gridDim.x, (int)blockIdx.x);
#ifndef SKIP_GEMM
    pg8::gemm_phase<Epi, pg8::StaticOrder, true, true>((PG8_LAS unsigned char*)lds, g, S, E, wv);
#endif
}
template <class Epi> __device__ __forceinline__ void run_gemm_fused(LAS char* lds, const u16* A, const u16* Bt, int N, int K, const Epi& E, int wv) {
    pg8::Gemm g{A, Bt, M, N, K}; pg8::StaticOrder S; S.init(M, N, (int)gridDim.x, (int)blockIdx.x);
    pg8::gemm_phase<Epi, pg8::StaticOrder, false, true>((PG8_LAS unsigned char*)lds, g, S, E, wv);
}
__device__ __forceinline__ void ffn_block(const XcdBarrier& bar, const Params& P, LAS char* lds, const float* modl, int mi, size_t w_in, size_t w_out,
                                          const float* ngain, const float* nmod, int nshift, int nscale, int bank, int wv, int ca0 = 0, int ca1 = 0, int cb0 = 0, int cb1 = 0) {
    unsigned char* ws = P.ws;
    { pg8::EpiSwiglu E{(u16*)(ws + WS_G), FF}; run_gemm(lds, (const u16*)(ws + WS_XN), (const u16*)(ws + w_in), 2 * FF, DM, E, wv); }
    if (ca1 > ca0 && gridDim.x == 256) copy_items(P, lds, ca0, ca1, 32, wv);
    xcd_barrier(bar);
    { pg8::EpiResidNorm E{P.out, modl + (mi + 2) * 1024, ngain, nmod, (u16*)(ws + WS_XN), (float*)(ws + WS_XBUF), (unsigned*)(ws + WS_CTL + 16384 + (size_t)bank * 12288), 0.5f, nshift, nscale, 0};
      run_gemm_fused(lds, (const u16*)(ws + WS_G), (const u16*)(ws + w_out), DM, FF, E, wv); }
    if (cb1 > cb0 && gridDim.x == 256) copy_items(P, lds, cb0, cb1, 192, wv);
    xcd_barrier(bar);
}

__global__ void __launch_bounds__(512, 2) fwd_megakernel(Params P) {
    extern __shared__ __attribute__((aligned(16))) unsigned char lds_raw[];
    LAS char* lds = (LAS char*)lds_raw;
    cg::grid_group grid = cg::this_grid();
    const int wv = __builtin_amdgcn_readfirstlane((int)(threadIdx.x >> 6));
    volatile LAS unsigned* bst = (volatile LAS unsigned*)(lds + LDS_BARST);
    if (threadIdx.x < 2) bst[threadIdx.x] = 0u;
    __syncthreads();
    if (threadIdx.x >= 2 && threadIdx.x < 4) bst[threadIdx.x] = 0u;
    __syncthreads();
    const XcdBarrier bar = xcd_barrier_post((unsigned*)(P.ws + WS_CTL), bst);
    XcdBarrier bar2; bar2.bar = (unsigned*)(P.ws + WS_CTL + 98304); bar2.x = bar.x; bar2.st = bst + 2;
    if (gridDim.x == 256 && blockIdx.x >= 64 && threadIdx.x == 0) (void)xb_add(&bar2.bar[XB_XCNT(bar2.x)], 1u);
    unsigned char* ws = P.ws;
    const float* MOD0 = (const float*)(ws + WS_MOD); const float* MOD1 = MOD0 + 3 * NMOD;
    float* XB = (float*)(ws + WS_XBUF);

    phase0(P, lds, wv);
    grid.sync();
    normmod_phase<true>(P, P.in[10], MOD0, 0, 1, wv);
    xcd_barrier(bar);
    ffn_block(bar, P, lds, MOD0, 0, WS_WIN00, WS_WOUT00, P.in[13], MOD0, 3, 4, 0, wv, 2, 6, 6, 8);
    if (gridDim.x != 256) { copy_items(P, lds, 2, 12, 0, wv); xcd_barrier(bar); }
    { pg8::EpiQKV E{(u16*)(ws + WS_Q), (u16*)(ws + WS_KB), (u16*)(ws + WS_VB), P.out + OUT_NK, P.out + OUT_NV, P.in[15], P.in[16], (const float*)(ws + WS_ROPE), (PG8_LAS float*)(lds + LDS_RED)};
      run_gemm(lds, (const u16*)(ws + WS_XN), (const u16*)(ws + WS_WQKV), 1536, DM, E, wv); }
    if (gridDim.x == 256) copy_items(P, lds, 8, 10, 32, wv);
    cache_copy(P, wv);
    xcd_barrier(bar);
    attn_phase(P, (char*)lds_raw, wv);
    xcd_barrier(bar);
    { pg8::EpiResidNorm E{P.out, MOD0 + 5 * 1024, P.in[26], MOD0, (u16*)(ws + WS_XN), XB, (unsigned*)(ws + WS_CTL + 16384 + 1 * 12288), 1.0f, 6, 7, 0};
      run_gemm_fused(lds, (const u16*)(ws + WS_O), (const u16*)(ws + WS_WO), DM, DM, E, wv); }
    xcd_barrier(bar);
    ffn_block(bar, P, lds, MOD0, 6, WS_WIN01, WS_WOUT01, P.in[10] + DM, MOD1, 0, 1, 2, wv, 10, 12, 0, 0);
    ffn_block(bar, P, lds, MOD1, 0, WS_WIN10, WS_WOUT10, P.in[13] + DM, MOD1, 3, 4, 3, wv);
    { pg8::EpiDN E{(u16*)(ws + WS_QKVR), (u16*)(ws + WS_Z), (float*)(ws + WS_AB)}; run_gemm(lds, (const u16*)(ws + WS_XN), (const u16*)(ws + WS_WDNIN), 4096, DM, E, wv); }
    ab_tile_phase(P, lds, wv);
    xcd_barrier(bar);
    if (gridDim.x == 256) {
        for (int t = blockIdx.x; t < 128 * 8; t += 256) d1_task(P, 64 + (t >> 3), t & 7, lds, wv);
        xcd_barrier(bar);
        if (blockIdx.x < 64) {
            const int b_ = blockIdx.x, t = (((b_ & 7) * 4 + (b_ >> 4)) << 1) | ((b_ >> 3) & 1), rem = t & 31;
            d2_chain(P, 16 + (t >> 5), rem >> 2, (rem >> 1) & 1, rem & 1, lds, wv);
        } else {
            for (int t = blockIdx.x - 64; t < 64 * 8; t += 192) d1_task(P, t >> 3, t & 7, lds, wv);
            xcd_barrier_n(bar2, 192u);
            for (int t = blockIdx.x - 64; t < 512; t += 192) { const int rem = t & 31; d2_chain(P, t >> 5, rem >> 2, (rem >> 1) & 1, rem & 1, lds, wv); __syncthreads(); }
        }
    } else {
        for (int t = blockIdx.x; t < 192 * 8; t += gridDim.x) d1_task(P, t >> 3, t & 7, lds, wv);
        xcd_barrier(bar);
        for (int t = blockIdx.x; t < 576; t += gridDim.x) {
            int seq, rem;
            if (t < 64) { seq = 16 + (t >> 5); rem = t & 31; } else { seq = (t - 64) >> 5; rem = (t - 64) & 31; }
            d2_chain(P, seq, rem >> 2, (rem >> 1) & 1, rem & 1, lds, wv);
            __syncthreads();
        }
    }
    xcd_barrier(bar);
    d3_phase(P, wv);
    xcd_barrier(bar);
    { pg8::EpiResidNorm E{P.out, MOD1 + 5 * 1024, P.in[26] + DM, MOD1, (u16*)(ws + WS_XN), XB, (unsigned*)(ws + WS_CTL + 16384 + 4 * 12288), 1.0f, 6, 7, 0};
      run_gemm_fused(lds, (const u16*)(ws + WS_O2), (const u16*)(ws + WS_WDNO), DM, DM, E, wv); }
    xcd_barrier(bar);
    ffn_block(bar, P, lds, MOD1, 6, WS_WIN11, WS_WOUT11, P.in[29], MOD1, 0, -1, 5, wv);
}

extern "C" void kernel_launch(void* const* d_in, const int* in_sizes, int n_in, void* d_out, int out_size, void* d_ws, size_t ws_size, hipStream_t stream) {
    static int grid = 0;
    if (grid == 0) {
        if (n_in != 30 || out_size != 18874368 || ws_size < WS_END) { fprintf(stderr, "kernel_launch: unexpected shapes n_in %d out %d ws %zu (need %zu)\n", n_in, out_size, ws_size, (size_t)WS_END); grid = -1; return; }
        int dev = 0, cus = 0, per_cu = 0;
        hipGetDevice(&dev); hipDeviceGetAttribute(&cus, hipDeviceAttributeMultiprocessorCount, dev);
        if (hipFuncSetAttribute((const void*)fwd_megakernel, hipFuncAttributeMaxDynamicSharedMemorySize, LDS_BYTES) != hipSuccess) { fprintf(stderr, "kernel_launch: hipFuncSetAttribute failed\n"); grid = -1; return; }
        if (hipOccupancyMaxActiveBlocksPerMultiprocessor(&per_cu, (const void*)fwd_megakernel, 512, LDS_BYTES) != hipSuccess || per_cu < 1) { fprintf(stderr, "kernel_launch: occupancy query failed (%d)\n", per_cu); (void)hipGetLastError(); per_cu = 1; }
        grid = cus * 1;
    }
    if (grid < 0) return;
    if (hipMemsetAsync((char*)d_ws + WS_CTL, 0, CTL_BYTES, stream) != hipSuccess) { fprintf(stderr, "kernel_launch: memset failed\n"); return; }
    Params p{};
    for (int i = 0; i < 30; ++i) p.in[i] = (const float*)d_in[i];
    p.out = (float*)d_out; p.ws = (unsigned char*)d_ws;
    void* args[] = {&p};
    hipError_t e = hipLaunchCooperativeKernel((const void*)fwd_megakernel, dim3(grid), dim3(512), args, LDS_BYTES, stream);
    if (e != hipSuccess) fprintf(stderr, "cooperative launch failed: %s (grid %d)\n", hipGetErrorString(e), grid);
}
```

```cpp
#include <hip/hip_runtime.h>
#include <hip/hip_bf16.h>
#include <hip/hip_cooperative_groups.h>
#include <cstdio>
#include <cstdint>
namespace cg = cooperative_groups;
#ifndef REP_D2
#define REP_D2 0
#endif
#ifndef REP_ATT
#define REP_ATT 0
#endif
#ifndef REP_D1
#define REP_D1 0
#endif
#ifndef REP_G1
#define REP_G1 0
#endif
#ifndef REP_P0
#define REP_P0 0
#endif
#ifndef REP_NM
#define REP_NM 0
#endif
typedef __bf16 bf16x2_t __attribute__((ext_vector_type(2)));
typedef float f32x2_t __attribute__((ext_vector_type(2)));
__device__ __forceinline__ unsigned cvtpk_rne(float lo, float hi) { f32x2_t v = {lo, hi}; bf16x2_t b = __builtin_convertvector(v, bf16x2_t); return __builtin_bit_cast(unsigned, b); }
__device__ __forceinline__ int ltid(int wv) { int l; asm volatile("v_mbcnt_lo_u32_b32 %0, -1, 0\n\tv_mbcnt_hi_u32_b32 %0, -1, %0" : "=v"(l)); return (wv << 6) | l; }

namespace pg8 {
#define PG8_LAS __attribute__((address_space(3)))
typedef unsigned short bf16_t;
typedef short bf16x8 __attribute__((ext_vector_type(8)));
typedef float f32x4 __attribute__((ext_vector_type(4)));
typedef unsigned u32x4 __attribute__((ext_vector_type(4)));
constexpr int BM = 256, BK = 64, HALF = 128, HTB = HALF * BK * 2  , STAGE_BYTES = 8 * HTB, NXCD = 8, WGM = 8;

__host__ __device__ __forceinline__ int lds_byte(int r, int c) { const int st = (r >> 4) * 2 + (c >> 5), rr = r & 15, cc = c & 31, ob = rr * 64 + cc * 2; return st * 1024 + (ob ^ (((ob >> 9) & 1) << 5)); }
__host__ __device__ __forceinline__ void stage_rc(int b, int& R, int& C) { const int st = b / 1024, sb = b % 1024, swz = sb ^ (((sb >> 9) & 1) << 5); R = (st >> 1) * 16 + swz / 64; C = (st & 1) * 32 + (swz % 64) / 2; }
__host__ __device__ __forceinline__ int perm32(int rho) { const int n = rho >> 4, i = rho & 15; return 8 * (i >> 2) + 4 * n + (i & 3); }

struct Unit { int pm, pn; };
struct Gemm { const bf16_t* A; const bf16_t* Bt; int M, N, K; };

struct StaticOrder {
    int nM, nN, nwg, G, c;
    __host__ __device__ void init(int M, int N, int G_, int c_) { nM = M / BM; nN = N / BM; nwg = nM * nN; G = G_; c = c_; }
    __host__ __device__ bool next(int i, Unit& u) const {
        const long L = (long)i * G + c; if (L >= nwg) return false;
        int wgid = (int)L; { const int q = nwg / NXCD, r = nwg % NXCD, xcd = wgid % NXCD, off = wgid / NXCD; wgid = (xcd < r ? xcd * (q + 1) : r * (q + 1) + (xcd - r) * q) + off; }
        const int nig = WGM * nN, gid = wgid / nig, fm = gid * WGM, gsz = (nM - fm) < WGM ? (nM - fm) : WGM;
        u.pm = fm + ((wgid % nig) % gsz); u.pn = (wgid % nig) / gsz; return true;
    }
    __device__ __forceinline__ void a_ready(const Unit&) const {}
    __device__ __forceinline__ void done(const Unit&) const {}
};

__device__ __forceinline__ unsigned cvt_pk_bf16(float lo, float hi) { return cvtpk_rne(lo, hi); }
typedef unsigned u32x2 __attribute__((ext_vector_type(2)));
__device__ __forceinline__ float silu_f(float x) { return x * __builtin_amdgcn_rcpf(1.0f + __expf(-x)); }

struct EpiSwiglu {
    static constexpr bool PERM = true, AFTER_DRAIN = false;
    bf16_t* G; int ldg;
    __device__ __forceinline__ void operator()(const f32x4 (&acc)[2][2][4][2], const Unit& u, int wr, int wc, int fr, int fq) const {
        asm volatile("" : "+v"(fr), "+v"(fq));
        const int row0 = u.pm * BM + wr * 64 + fr, col0 = u.pn * HALF + wc * 32 + 8 * fq;
#pragma unroll
        for (int ai = 0; ai < 2; ++ai)
#pragma unroll
            for (int m = 0; m < 4; ++m) {
                bf16_t* rowp = G + (size_t)(row0 + ai * HALF + m * 16) * ldg + col0;
                const f32x4 a0 = acc[ai][0][m][0], a1 = acc[ai][0][m][1], b0 = acc[ai][1][m][0], b1 = acc[ai][1][m][1];
                f32x4 v0, v1;
#pragma unroll
                for (int j = 0; j < 4; ++j) { v0[j] = silu_f(a0[j]) * b0[j]; v1[j] = silu_f(a1[j]) * b1[j]; }
                u32x4 w; w.x = cvt_pk_bf16(v0[0], v0[1]); w.y = cvt_pk_bf16(v0[2], v0[3]); w.z = cvt_pk_bf16(v1[0], v1[1]); w.w = cvt_pk_bf16(v1[2], v1[3]);
                *(u32x4*)rowp = w;
            }
    }
};
struct EpiResid {
    static constexpr bool PERM = false, AFTER_DRAIN = false;
    float* h; const float* gate; float coef;
    __device__ __forceinline__ void operator()(const f32x4 (&acc)[2][2][4][2], const Unit& u, int wr, int wc, int fr, int fq) const {
        asm volatile("" : "+v"(fr), "+v"(fq));
        const int cond = u.pm < 16 ? 0 : (u.pm < 32 ? 1 : 2);
        const int row0 = u.pm * BM + wr * 64 + fr, col0 = u.pn * BM + wc * 32 + 4 * fq;
        const float* g = gate + cond * 9216 + col0;
        f32x4 gv[2][2];
#pragma unroll
        for (int bj = 0; bj < 2; ++bj)
#pragma unroll
            for (int n = 0; n < 2; ++n) gv[bj][n] = *(const f32x4*)(g + bj * HALF + n * 16) * coef;
#pragma unroll
        for (int ai = 0; ai < 2; ++ai)
#pragma unroll
            for (int m = 0; m < 4; ++m) { float* rowp = h + (size_t)(row0 + ai * HALF + m * 16) * 1024 + col0;
#pragma unroll
                for (int bj = 0; bj < 2; ++bj)
#pragma unroll
                    for (int n = 0; n < 2; ++n) { float* p = rowp + bj * HALF + n * 16; *(f32x4*)p = *(const f32x4*)p + gv[bj][n] * acc[ai][bj][m][n]; } }
    }
};

struct EpiResidNorm {
    static constexpr bool PERM = false, AFTER_DRAIN = true;
    float* h; const float* gate; const float* ngain; const float* nmod; bf16_t* XN; float* xbuf; unsigned* cnt; float coef; int ishift, iscale, pad_;
    __device__ __forceinline__ void operator()(const f32x4 (&)[2][2][4][2], const Unit&, int, int, int, int) const {}
    __device__ __forceinline__ void fused(f32x4 (&acc)[2][2][4][2], const Unit& u, int wr, int wc, int fr, int fq, PG8_LAS unsigned char* lds, int wid, int lane) const {
        float* const h_ = h; const float* const gate_ = gate; const float coef_ = coef; const float* const ngain_ = ngain; const float* const nmod_ = nmod; const int ishift_ = ishift, iscale_ = iscale; bf16_t* const XN_ = XN; float* const xbuf_ = xbuf; unsigned* const cnt_ = cnt;
        asm volatile("" : "+v"(fr), "+v"(fq));
        const int cond = u.pm < 16 ? 0 : (u.pm < 32 ? 1 : 2);
        const int row0 = u.pm * BM + wr * 64 + fr, col0 = u.pn * BM + wc * 32 + 4 * fq;
        PG8_LAS float* Pt = (PG8_LAS float*)lds; PG8_LAS float* St = Pt + 1024;
        {   const float* g = gate_ + cond * 9216 + col0;
            f32x4 gv[2][2];
#pragma unroll
            for (int bj = 0; bj < 2; ++bj)
#pragma unroll
                for (int n = 0; n < 2; ++n) gv[bj][n] = *(const f32x4*)(g + bj * HALF + n * 16) * coef_;
#pragma unroll
            for (int ai = 0; ai < 2; ++ai)
#pragma unroll
                for (int m = 0; m < 4; ++m) { float* rowp = h_ + (size_t)(row0 + ai * HALF + m * 16) * 1024 + col0; float s = 0.f;
#pragma unroll
                    for (int bj = 0; bj < 2; ++bj)
#pragma unroll
                        for (int n = 0; n < 2; ++n) { float* p = rowp + bj * HALF + n * 16; const f32x4 hv = *(const f32x4*)p + gv[bj][n] * acc[ai][bj][m][n];
                            acc[ai][bj][m][n] = hv; if (iscale_ >= 0) *(f32x4*)p = hv; s += (hv[0] * hv[0] + hv[1] * hv[1]) + (hv[2] * hv[2] + hv[3] * hv[3]); }
                    s += __shfl_xor(s, 16); s += __shfl_xor(s, 32);
                    if (fq == 0) Pt[(ai * HALF + wr * 64 + m * 16 + fr) * 4 + wc] = s;
                    asm volatile("" ::: "memory"); }
        }
        asm volatile("s_waitcnt lgkmcnt(0)" ::: "memory"); __builtin_amdgcn_s_barrier(); asm volatile("" ::: "memory");
        const int row = wid * 32 + (lane & 31);
        if (lane < 32) { const f32x4 p4 = *(const PG8_LAS f32x4*)(Pt + row * 4);
            __hip_atomic_store(xbuf_ + ((size_t)u.pm * BM + row) * 4 + u.pn, (p4[0] + p4[1]) + (p4[2] + p4[3]), __ATOMIC_RELAXED, __HIP_MEMORY_SCOPE_AGENT); }
        asm volatile("s_waitcnt vmcnt(0)" ::: "memory");
        if (lane == 0) __hip_atomic_fetch_add(cnt_ + 64 * u.pm, 1u, __ATOMIC_RELAXED, __HIP_MEMORY_SCOPE_AGENT);
        if (wid == 0) { unsigned sp = 0;
            while ((unsigned)__builtin_amdgcn_readfirstlane(__hip_atomic_load(cnt_ + 64 * u.pm, __ATOMIC_RELAXED, __HIP_MEMORY_SCOPE_AGENT)) < 32u) { __builtin_amdgcn_s_sleep(2); if (++sp > (1u << 22)) break; }
            __builtin_amdgcn_fence(__ATOMIC_ACQUIRE, "agent"); }
        asm volatile("s_waitcnt vmcnt(0) lgkmcnt(0)" ::: "memory"); __builtin_amdgcn_s_barrier(); asm volatile("" ::: "memory");
        if (lane < 32) { const float* sl = xbuf_ + ((size_t)u.pm * BM + row) * 4; float t = 0.f;
#pragma unroll
            for (int k = 0; k < 4; ++k) t += __hip_atomic_load(sl + k, __ATOMIC_RELAXED, __HIP_MEMORY_SCOPE_AGENT);
            St[row] = 1.0f / sqrtf(t * (1.0f / 1024.0f) + 1e-6f); }
        asm volatile("s_waitcnt vmcnt(0) lgkmcnt(0)" ::: "memory"); __builtin_amdgcn_s_barrier(); asm volatile("" ::: "memory");
        const float* gp = ngain_ + col0; const float* shp = nmod_ + cond * 9216 + (iscale_ >= 0 ? ishift_ : 0) * 1024 + col0; const float* scp = nmod_ + cond * 9216 + (iscale_ >= 0 ? iscale_ : 0) * 1024 + col0;
#pragma unroll
        for (int ai = 0; ai < 2; ++ai)
#pragma unroll
            for (int m = 0; m < 4; ++m) { const int r = ai * HALF + wr * 64 + m * 16 + fr; const float rinv = St[r]; const size_t off = (size_t)(u.pm * BM + r) * 1024 + col0;
#pragma unroll
                for (int bj = 0; bj < 2; ++bj)
#pragma unroll
                    for (int n = 0; n < 2; ++n) { const int co = bj * HALF + n * 16; const f32x4 gn = *(const f32x4*)(gp + co); f32x4 y = acc[ai][bj][m][n] * rinv * gn;
                        if (iscale_ >= 0) { const f32x4 sv = *(const f32x4*)(shp + co), cv = *(const f32x4*)(scp + co); y = y * (cv + 1.0f) + sv;
                            u32x2 w; w.x = cvt_pk_bf16(y[0], y[1]); w.y = cvt_pk_bf16(y[2], y[3]); *(u32x2*)(XN_ + off + co) = w; }
                        else *(f32x4*)(h_ + off + co) = y; }
                asm volatile("" ::: "memory"); }
    }
};
struct EpiQKV {
    static constexpr bool PERM = false, AFTER_DRAIN = false;
    bf16_t *Q, *KB, *VB; float *outk, *outv; const float *qg, *kg, *rope; PG8_LAS float* red;
    __device__ __forceinline__ void operator()(const f32x4 (&acc)[2][2][4][2], const Unit& u, int wr, int wc, int fr, int fq) const {
        asm volatile("" : "+v"(fr), "+v"(fq));
        const int pn = u.pn;
        if (pn < 5) {
#pragma unroll
            for (int ai = 0; ai < 2; ++ai)
#pragma unroll
                for (int m = 0; m < 4; ++m)
#pragma unroll
                    for (int bj = 0; bj < 2; ++bj) {
                        const f32x4 x = acc[ai][bj][m][0], y = acc[ai][bj][m][1];
                        float s = (x[0] * x[0] + x[1] * x[1]) + (x[2] * x[2] + x[3] * x[3]) + (y[0] * y[0] + y[1] * y[1]) + (y[2] * y[2] + y[3] * y[3]);
                        s += __shfl_xor(s, 16); s += __shfl_xor(s, 32);
                        if (fq == 0) red[((ai * HALF + wr * 64 + m * 16 + fr) * 2 + bj) * 4 + wc] = s;
                    }
            asm volatile("s_waitcnt lgkmcnt(0)" ::: "memory"); __builtin_amdgcn_s_barrier(); asm volatile("" ::: "memory");
            const float* gain = pn < 4 ? qg : kg;
            const int d0 = (wc >> 1) * 64 + (wc & 1) * 16 + fq * 4, f0 = (wc & 1) * 16 + fq * 4;
            const f32x4 g1 = *(const f32x4*)(gain + d0), g2 = *(const f32x4*)(gain + d0 + 32);
#pragma unroll
            for (int ai = 0; ai < 2; ++ai)
#pragma unroll
                for (int m = 0; m < 4; ++m) {
                    const int rl = ai * HALF + wr * 64 + m * 16 + fr, row = u.pm * BM + rl;
                    f32x4 cs = {1.f, 1.f, 1.f, 1.f}, sn = {0.f, 0.f, 0.f, 0.f};
                    if (u.pm >= 16) { const int t = (row - 4096) & 4095, pos = (wc >> 1) ? (t & 63) : (t >> 6);
                        cs = *(const f32x4*)(rope + pos * 32 + f0); sn = *(const f32x4*)(rope + 2048 + pos * 32 + f0); }
                    const int krow = row < 4096 ? row : 4096 + ((row - 4096) >> 12) * 4608 + 512 + ((row - 4096) & 4095);
#pragma unroll
                    for (int bj = 0; bj < 2; ++bj) {
                        const f32x4 pr = *(const PG8_LAS f32x4*)(red + (rl * 2 + bj) * 4);
                        const float rinv = __builtin_amdgcn_rsqf(((pr[0] + pr[1]) + (pr[2] + pr[3])) * (1.0f / 128.0f) + 1e-6f);
                        const f32x4 x1 = acc[ai][bj][m][0] * rinv * g1, x2 = acc[ai][bj][m][1] * rinv * g2;
                        const f32x4 o1 = x1 * cs - x2 * sn, o2 = x2 * cs + x1 * sn;
                        u32x2 w1, w2; w1.x = cvt_pk_bf16(o1[0], o1[1]); w1.y = cvt_pk_bf16(o1[2], o1[3]); w2.x = cvt_pk_bf16(o2[0], o2[1]); w2.y = cvt_pk_bf16(o2[2], o2[3]);
                        if (pn < 4) { bf16_t* dst = Q + (size_t)row * 1024 + (pn * 2 + bj) * 128 + d0; *(u32x2*)dst = w1; *(u32x2*)(dst + 32) = w2; }
                        else { bf16_t* dst = KB + (size_t)krow * 256 + bj * 128 + d0; *(u32x2*)dst = w1; *(u32x2*)(dst + 32) = w2;
                            if (row < 4096) { float* ok = outk + (size_t)row * 256 + bj * 128 + d0; *(f32x4*)ok = o1; *(f32x4*)(ok + 32) = o2; } }
                    }
                    asm volatile("" ::: "memory");
                }
        } else {
#pragma unroll
            for (int ai = 0; ai < 2; ++ai)
#pragma unroll
                for (int m = 0; m < 4; ++m) {
                    const int row = u.pm * BM + ai * HALF + wr * 64 + m * 16 + fr;
                    const int krow = row < 4096 ? row : 4096 + ((row - 4096) >> 12) * 4608 + 512 + ((row - 4096) & 4095);
#pragma unroll
                    for (int bj = 0; bj < 2; ++bj)
#pragma unroll
                        for (int n = 0; n < 2; ++n) {
                            const int c0 = bj * HALF + wc * 32 + n * 16 + 4 * fq; const f32x4 v = acc[ai][bj][m][n];
                            u32x2 w; w.x = cvt_pk_bf16(v[0], v[1]); w.y = cvt_pk_bf16(v[2], v[3]);
                            *(u32x2*)(VB + (size_t)krow * 256 + c0) = w;
                            if (row < 4096) *(f32x4*)(outv + (size_t)row * 256 + c0) = v;
                        }
                    asm volatile("" ::: "memory");
                }
        }
    }
};
struct EpiDN {
    static constexpr bool PERM = false, AFTER_DRAIN = false;
    bf16_t *QKV, *Z; float* AB;
    __device__ __forceinline__ void operator()(const f32x4 (&acc)[2][2][4][2], const Unit& u, int wr, int wc, int fr, int fq) const {
        asm volatile("" : "+v"(fr), "+v"(fq));
        const int pn = u.pn, row0 = u.pm * BM + wr * 64 + fr;
        if (pn < 16) {
            bf16_t* base = pn < 12 ? QKV : Z; const int ld = pn < 12 ? 3072 : 1024, colb = (pn < 12 ? pn : pn - 12) * BM + wc * 32 + 4 * fq;
#pragma unroll
            for (int ai = 0; ai < 2; ++ai)
#pragma unroll
                for (int m = 0; m < 4; ++m) { bf16_t* rowp = base + (size_t)(row0 + ai * HALF + m * 16) * ld + colb;
#pragma unroll
                    for (int bj = 0; bj < 2; ++bj)
#pragma unroll
                        for (int n = 0; n < 2; ++n) { const f32x4 v = acc[ai][bj][m][n]; u32x2 w; w.x = cvt_pk_bf16(v[0], v[1]); w.y = cvt_pk_bf16(v[2], v[3]); *(u32x2*)(rowp + bj * HALF + n * 16) = w; } }
        } else if (wc == 0) {
#pragma unroll
            for (int ai = 0; ai < 2; ++ai)
#pragma unroll
                for (int m = 0; m < 4; ++m) { float* rowp = AB + (size_t)(row0 + ai * HALF + m * 16) * 32 + 4 * fq;
#pragma unroll
                    for (int n = 0; n < 2; ++n) *(f32x4*)(rowp + n * 16) = acc[ai][0][m][n]; }
        }
    }
};
template <class Epi, class Sched, bool ALIGN_EPI = false, bool SP2 = false>
__device__ __forceinline__ void gemm_phase(PG8_LAS unsigned char* lds, const Gemm g, const Sched& S, const Epi& E, int wv) {
    const int tid = ltid(wv), wid = __builtin_amdgcn_readfirstlane(tid >> 6), lane = tid & 63, wr = wid >> 2, wc = wid & 3, fr = lane & 15, fq = lane >> 4;
    const int K = g.K, nt = K / BK;
    unsigned voffA[2], voffB[2];
#pragma unroll
    for (int i = 0; i < 2; ++i) { int R, C; stage_rc(tid * 16 + i * 8192, R, C); const int Rb = Epi::PERM ? ((R & ~31) + perm32(R & 31)) : R;
        voffA[i] = (unsigned)(R * K + C) * 2u; voffB[i] = (unsigned)(Rb * K + C) * 2u; }
    const size_t kstep = (size_t)(BK * 2);
    const size_t hstep = (size_t)HALF * K * 2;
    const size_t tstep = 2 * hstep;
    const unsigned ldsw = (unsigned)wid * 1024u;
    const int aoff = lds_byte(wr * 64 + fr, fq * 8), boff = lds_byte(wc * 32 + fr, fq * 8);
#define PG8_SA(b, h) (((b) * 2 + (h)) * HTB)
#define PG8_SB(b, h) ((4 + (b) * 2 + (h)) * HTB)
#define PG8_STAGE(bufoff, gbase, voff) do { _Pragma("unroll") for (int _i = 0; _i < 2; ++_i) \
        __builtin_amdgcn_global_load_lds((const unsigned*)((const char*)(gbase) + (voff)[_i]), (PG8_LAS unsigned*)(lds + (bufoff) + ldsw + _i * 8192), 16, 0, 0); } while (0)
#define PG8_LDA(dst, b, h) do { _Pragma("unroll") for (int m = 0; m < 4; ++m) _Pragma("unroll") for (int k = 0; k < 2; ++k) dst[m][k] = *(const PG8_LAS bf16x8*)(lds + PG8_SA(b, h) + aoff + m * 2048 + k * 1024); } while (0)
#define PG8_LDB(dst, b, h) do { _Pragma("unroll") for (int n = 0; n < 2; ++n) _Pragma("unroll") for (int k = 0; k < 2; ++k) dst[n][k] = *(const PG8_LAS bf16x8*)(lds + PG8_SB(b, h) + boff + n * 2048 + k * 1024); } while (0)
#define PG8_MMA(ai, bj, At, Bt) do { __builtin_amdgcn_s_setprio(1); _Pragma("unroll") for (int m = 0; m < 4; ++m) _Pragma("unroll") for (int n = 0; n < 2; ++n) _Pragma("unroll") for (int k = 0; k < 2; ++k) \
        acc[ai][bj][m][n] = __builtin_amdgcn_mfma_f32_16x16x32_bf16(Bt[n][k], At[m][k], acc[ai][bj][m][n], 0, 0, 0); __builtin_amdgcn_s_setprio(0); } while (0)
#define PG8_WAIT_V(n) asm volatile("s_waitcnt vmcnt(" #n ")" ::: "memory")
#define PG8_WAIT_L(n) asm volatile("s_waitcnt lgkmcnt(" #n ")" ::: "memory")
#define PG8_BAR __builtin_amdgcn_s_barrier()
#define PG8_SCHED __builtin_amdgcn_sched_barrier(0)
    Unit cur, nxt; int ui = 0;
    if (!S.next(0, cur)) return;
    f32x4 acc[2][2][4][2];
#pragma unroll
    for (int a = 0; a < 2; ++a)
#pragma unroll
        for (int b = 0; b < 2; ++b)
#pragma unroll
            for (int m = 0; m < 4; ++m)
#pragma unroll
                for (int n = 0; n < 2; ++n) acc[a][b][m][n] = (f32x4){0.f, 0.f, 0.f, 0.f};
    bf16x8 At[4][2], B0[2][2], B1[2][2];
    const char* cA = (const char*)g.A + (size_t)cur.pm * tstep; const char* cB = (const char*)g.Bt + (size_t)cur.pn * tstep;
    S.a_ready(cur);
    if constexpr (SP2) {
        PG8_STAGE(PG8_SB(0, 0), cB, voffB); PG8_STAGE(PG8_SB(0, 1), cB + hstep, voffB); PG8_STAGE(PG8_SA(0, 0), cA, voffA); PG8_STAGE(PG8_SA(0, 1), cA + hstep, voffA);
        if (wr == 1) PG8_BAR;
        PG8_WAIT_V(2); PG8_BAR;
        PG8_STAGE(PG8_SB(1, 0), cB + kstep, voffB); PG8_STAGE(PG8_SA(1, 0), cA + kstep, voffA); PG8_STAGE(PG8_SB(1, 1), cB + hstep + kstep, voffB);
        PG8_WAIT_V(6); PG8_BAR;
    } else {
        PG8_STAGE(PG8_SB(0, 0), cB, voffB); PG8_STAGE(PG8_SA(0, 0), cA, voffA); PG8_STAGE(PG8_SB(0, 1), cB + hstep, voffB); PG8_STAGE(PG8_SA(0, 1), cA + hstep, voffA);
        if (wr == 1) PG8_BAR;
        PG8_WAIT_V(4); PG8_BAR;
        PG8_STAGE(PG8_SB(1, 0), cB + kstep, voffB); PG8_STAGE(PG8_SA(1, 0), cA + kstep, voffA); PG8_STAGE(PG8_SB(1, 1), cB + hstep + kstep, voffB);
        PG8_WAIT_V(6); PG8_BAR;
    }
    for (;;) {
        const bool has_next = S.next(ui + 1, nxt);
        const char* nA = has_next ? (const char*)g.A + (size_t)nxt.pm * tstep : cA; const char* nB = has_next ? (const char*)g.Bt + (size_t)nxt.pn * tstep : cB;
        for (int t = 0; t < nt; t += 2) {
            const bool last = (t == nt - 2);
            const char* a1 = cA + (size_t)(t + 1) * kstep;
            const char* a2 = last ? nA : cA + (size_t)(t + 2) * kstep; const char* b2 = last ? nB : cB + (size_t)(t + 2) * kstep;
            const char* a3 = a2 + kstep; const char* b3 = b2 + kstep;
            if (last && has_next) S.a_ready(nxt);
            if constexpr (SP2) {
            PG8_LDB(B0, 0, 0); PG8_LDB(B1, 0, 1); PG8_SCHED; PG8_LDA(At, 0, 0); PG8_STAGE(PG8_SA(1, 1), a1 + hstep, voffA);
            PG8_WAIT_V(8); PG8_WAIT_L(0); PG8_BAR; PG8_MMA(0, 0, At, B0); PG8_MMA(0, 1, At, B1); PG8_BAR; PG8_SCHED;
            PG8_LDA(At, 0, 1); PG8_STAGE(PG8_SB(0, 0), b2, voffB); PG8_STAGE(PG8_SB(0, 1), b2 + hstep, voffB); PG8_STAGE(PG8_SA(0, 0), a2, voffA);
            PG8_WAIT_V(8); PG8_WAIT_L(0); PG8_BAR; PG8_MMA(1, 0, At, B0); PG8_MMA(1, 1, At, B1); PG8_BAR; PG8_SCHED;
            PG8_LDB(B0, 1, 0); PG8_LDB(B1, 1, 1); PG8_SCHED; PG8_LDA(At, 1, 0); PG8_STAGE(PG8_SA(0, 1), a2 + hstep, voffA);
            PG8_WAIT_V(8); PG8_WAIT_L(0); PG8_BAR; PG8_MMA(0, 0, At, B0); PG8_MMA(0, 1, At, B1); PG8_BAR; PG8_SCHED;
            PG8_LDA(At, 1, 1); PG8_STAGE(PG8_SB(1, 0), b3, voffB); PG8_STAGE(PG8_SB(1, 1), b3 + hstep, voffB); PG8_STAGE(PG8_SA(1, 0), a3, voffA);
            PG8_WAIT_V(8); PG8_WAIT_L(0); PG8_BAR; PG8_MMA(1, 0, At, B0); PG8_MMA(1, 1, At, B1); PG8_BAR; PG8_SCHED;
            } else {
            PG8_LDB(B0, 0, 0); PG8_SCHED; PG8_LDA(At, 0, 0); PG8_STAGE(PG8_SA(1, 1), a1 + hstep, voffA);
            PG8_WAIT_L(8); PG8_BAR; PG8_WAIT_L(0); PG8_MMA(0, 0, At, B0); PG8_BAR; PG8_SCHED;
            PG8_LDB(B1, 0, 1); PG8_STAGE(PG8_SB(0, 0), b2, voffB);
            PG8_BAR; PG8_WAIT_L(0); PG8_MMA(0, 1, At, B1); PG8_BAR;
            PG8_LDA(At, 0, 1); PG8_STAGE(PG8_SA(0, 0), a2, voffA);
            PG8_BAR; PG8_WAIT_L(0); PG8_MMA(1, 0, At, B0); PG8_BAR; PG8_SCHED;
            PG8_STAGE(PG8_SB(0, 1), b2 + hstep, voffB);
            PG8_WAIT_V(6); PG8_BAR; PG8_MMA(1, 1, At, B1); PG8_BAR;
            PG8_LDB(B0, 1, 0); PG8_SCHED; PG8_LDA(At, 1, 0); PG8_STAGE(PG8_SA(0, 1), a2 + hstep, voffA);
            PG8_WAIT_L(8); PG8_BAR; PG8_WAIT_L(0); PG8_MMA(0, 0, At, B0); PG8_BAR; PG8_SCHED;
            PG8_LDB(B1, 1, 1); PG8_STAGE(PG8_SB(1, 0), b3, voffB);
            PG8_BAR; PG8_WAIT_L(0); PG8_MMA(0, 1, At, B1); PG8_BAR;
            PG8_LDA(At, 1, 1); PG8_STAGE(PG8_SA(1, 0), a3, voffA);
            PG8_BAR; PG8_WAIT_L(0); PG8_MMA(1, 0, At, B0); PG8_BAR; PG8_SCHED;
            PG8_STAGE(PG8_SB(1, 1), b3 + hstep, voffB);
            PG8_WAIT_V(6); PG8_BAR; PG8_MMA(1, 1, At, B1); PG8_BAR;
            }
        }
        if constexpr (ALIGN_EPI) { if (wr == 0) PG8_BAR; }
        if constexpr (!Epi::AFTER_DRAIN) { E(acc, cur, wr, wc, fr, fq); S.done(cur); }
        if (!has_next) break;
#pragma unroll
        for (int a = 0; a < 2; ++a)
#pragma unroll
            for (int b = 0; b < 2; ++b)
#pragma unroll
                for (int m = 0; m < 4; ++m)
#pragma unroll
                    for (int n = 0; n < 2; ++n) acc[a][b][m][n] = (f32x4){0.f, 0.f, 0.f, 0.f};
        cur = nxt; cA = nA; cB = nB; ++ui;
        if constexpr (ALIGN_EPI) { if (wr == 1) PG8_BAR; }
    }
    PG8_WAIT_V(0);
    if constexpr (!ALIGN_EPI) { if (wr == 0) PG8_BAR; }
    PG8_BAR;
    if constexpr (Epi::AFTER_DRAIN) { E.fused(acc, cur, wr, wc, fr, fq, lds, wid, lane); S.done(cur); }
#undef PG8_SA
#undef PG8_SB
#undef PG8_STAGE
#undef PG8_LDA
#undef PG8_LDB
#undef PG8_MMA
#undef PG8_WAIT_V
#undef PG8_WAIT_L
#undef PG8_BAR
#undef PG8_SCHED
}
}

namespace att {
using bf16 = __hip_bfloat16;
constexpr int   D = 128, NW = 8, QBLK = 32, KVBLK = 64;
constexpr float SCALE = 0.088388347648318440f;
constexpr float THR = 8.f;
constexpr int SDEPTH = 1;
constexpr int LDQ = 1024, LDK = 256, LDO = 1024;
constexpr size_t SHM_V = KVBLK * D * 2, SHM_K = KVBLK * D * 2, SHM_ATTN = 2 * SHM_V + 2 * SHM_K + NW * 64 * 4;
using bf16x8 = __attribute__((ext_vector_type(8))) short;
using s16x4  = __attribute__((ext_vector_type(4))) short;
using f32x16 = __attribute__((ext_vector_type(16))) float;
using f32x8  = __attribute__((ext_vector_type(8))) float;
using u32x4  = __attribute__((ext_vector_type(4))) unsigned;
#define KSWZ(row, colB) ((row) * 256 + ((colB) ^ (((row) & 7) << 4)))
#define SBAR() __builtin_amdgcn_sched_barrier(0)
__device__ __forceinline__ int crow(int r, int hi) { return (r & 3) + 8 * (r >> 2) + 4 * hi; }
__device__ __forceinline__ unsigned cvtpk(float lo, float hi) {
  unsigned r; asm volatile("v_cvt_pk_bf16_f32 %0, %1, %2" : "=v"(r) : "v"(lo), "v"(hi)); return r;
}
template <typename TIn> struct Stage;
template <> struct Stage<bf16>  { using T = bf16x8;
  __device__ static __forceinline__ T ld8(const bf16* p) { return *reinterpret_cast<const bf16x8*>(p); }
  __device__ static __forceinline__ bf16x8 tobf(T x) { return x; } };
__device__ __forceinline__ void partialSM(f32x16& p0, f32x16& p1, float& m_reg, float& mn, float& alpha) {
  constexpr float C = SCALE * 1.4426950408889634f;
  float pmax = p0[0]; for (int r = 1; r < 16; ++r) pmax = fmaxf(pmax, p0[r]); for (int r = 0; r < 16; ++r) pmax = fmaxf(pmax, p1[r]);
  { auto rr = __builtin_amdgcn_permlane32_swap(__float_as_uint(pmax), __float_as_uint(pmax), false, false);
    pmax = fmaxf(__uint_as_float(rr[0]), __uint_as_float(rr[1])); }
  if (__builtin_expect(__all(pmax - m_reg <= THR / SCALE), 1)) { mn = m_reg; alpha = 1.f; }
  else { mn = fmaxf(m_reg, pmax); alpha = __builtin_amdgcn_exp2f((m_reg - mn) * C); m_reg = mn; }
  float mnC = -mn * C;
  for (int r = 0; r < 16; ++r) p0[r] = fmaf(p0[r], C, mnC); for (int r = 0; r < 16; ++r) p1[r] = fmaf(p1[r], C, mnC);
  for (int r = 0; r < 16; ++r) p0[r] = __builtin_amdgcn_exp2f(p0[r]);
}
__device__ __forceinline__ void finishSM(f32x16& p0, f32x16& p1, float alpha, float& l_reg, bf16x8& pa0, bf16x8& pa1, bf16x8& pa2, bf16x8& pa3) {
  for (int r = 0; r < 16; ++r) p1[r] = __builtin_amdgcn_exp2f(p1[r]);
  float ps = 0; for (int r = 0; r < 16; ++r) ps += p0[r]; for (int r = 0; r < 16; ++r) ps += p1[r];
  { auto rr = __builtin_amdgcn_permlane32_swap(__float_as_uint(ps), __float_as_uint(ps), false, false);
    ps = __uint_as_float(rr[0]) + __uint_as_float(rr[1]); }
  l_reg = l_reg * alpha + ps;
#define PK4(P, BASE, OUT) do { unsigned a0 = cvtpk(P[BASE + 0], P[BASE + 1]), a1 = cvtpk(P[BASE + 2], P[BASE + 3]);   \
    unsigned b0 = cvtpk(P[BASE + 4], P[BASE + 5]), b1 = cvtpk(P[BASE + 6], P[BASE + 7]);                              \
    auto r0 = __builtin_amdgcn_permlane32_swap(a0, b0, false, false); auto r1 = __builtin_amdgcn_permlane32_swap(a1, b1, false, false); \
    u32x4 w = {r0[0], r1[0], r0[1], r1[1]}; OUT = *reinterpret_cast<bf16x8*>(&w); } while (0)
  PK4(p0, 0, pa0); PK4(p0, 8, pa1); PK4(p1, 0, pa2); PK4(p1, 8, pa3);
#undef PK4
}
__device__ __forceinline__ void qkt(f32x16& p0, f32x16& p1, const bf16* Ks, const bf16x8* qr, int r32, int hi) {
  p0 = f32x16{}; p1 = f32x16{};
  for (int d0 = 0; d0 < 8; ++d0) { int cb = (d0 * 16 + hi * 8) * 2;
    bf16x8 b0 = *reinterpret_cast<const bf16x8*>((const char*)Ks + KSWZ(r32, cb));
    bf16x8 b1 = *reinterpret_cast<const bf16x8*>((const char*)Ks + KSWZ(32 + r32, cb));
    p0 = __builtin_amdgcn_mfma_f32_32x32x16_bf16(b0, qr[d0], p0, 0, 0, 0);
    p1 = __builtin_amdgcn_mfma_f32_32x32x16_bf16(b1, qr[d0], p1, 0, 0, 0); }
}
__device__ __forceinline__ int v_st(int k, int c) { const int kk = (k & ~0xC) | ((k & 4) << 1) | ((k & 8) >> 1); return ((kk >> 3) * 4 + (c >> 5)) * 512 + ((kk & 7) * 32 + (c & 31)) * 2; }
__device__ __forceinline__ int v_rd_base(int lane) { return ((lane & 3) << 3) | (((lane >> 2) & 3) << 6) | (((lane >> 4) & 1) << 5) | (((lane >> 5) & 1) << 8); }
constexpr int v_rd_off(int d0, int ks, int half) { return d0 * 512 + ks * 4096 + half * 2048; }
template <int OFF> __device__ __forceinline__ s16x4 tr_read(int vb) {
  s16x4 r; asm volatile("ds_read_b64_tr_b16 %0, %1 offset:%2" : "=&v"(r) : "v"(vb), "i"(OFF) : "memory"); return r;
}
template <int D0> __device__ __forceinline__ void pv_one(f32x16& od, int vb, bf16x8 pa0, bf16x8 pa1, bf16x8 pa2, bf16x8 pa3) {
  const s16x4 l0 = tr_read<v_rd_off(D0, 0, 0)>(vb), h0 = tr_read<v_rd_off(D0, 0, 1)>(vb), l1 = tr_read<v_rd_off(D0, 1, 0)>(vb), h1 = tr_read<v_rd_off(D0, 1, 1)>(vb);
  const s16x4 l2 = tr_read<v_rd_off(D0, 2, 0)>(vb), h2 = tr_read<v_rd_off(D0, 2, 1)>(vb), l3 = tr_read<v_rd_off(D0, 3, 0)>(vb), h3 = tr_read<v_rd_off(D0, 3, 1)>(vb);
  asm volatile("s_waitcnt lgkmcnt(0)" ::: "memory"); SBAR();
#define PK(L, H) (bf16x8){L[0], L[1], L[2], L[3], H[0], H[1], H[2], H[3]}
  od = __builtin_amdgcn_mfma_f32_32x32x16_bf16(pa0, PK(l0, h0), od, 0, 0, 0);
  od = __builtin_amdgcn_mfma_f32_32x32x16_bf16(pa1, PK(l1, h1), od, 0, 0, 0);
  od = __builtin_amdgcn_mfma_f32_32x32x16_bf16(pa2, PK(l2, h2), od, 0, 0, 0);
  od = __builtin_amdgcn_mfma_f32_32x32x16_bf16(pa3, PK(l3, h3), od, 0, 0, 0);
#undef PK
}
__device__ __forceinline__ void pv_d0(f32x16* o, int vb, bf16x8 pa0, bf16x8 pa1, bf16x8 pa2, bf16x8 pa3) {
  pv_one<0>(o[0], vb, pa0, pa1, pa2, pa3); pv_one<1>(o[1], vb, pa0, pa1, pa2, pa3); pv_one<2>(o[2], vb, pa0, pa1, pa2, pa3); pv_one<3>(o[3], vb, pa0, pa1, pa2, pa3);
}
template <typename TQ>
__device__ __forceinline__ void attn_dense_body(const TQ* __restrict__ Qb, const bf16* __restrict__ Kh, const bf16* __restrict__ Vh,
                                                unsigned short* __restrict__ Ob, int seq, char* lds, int wv) {
  using St = Stage<bf16>; using SQ = Stage<TQ>;
  const int tid = ltid(wv), wid = tid >> 6, lane = tid & 63, r32 = lane & 31, hi = lane >> 5;
  bf16* V_lds = (bf16*)lds; bf16* K_lds = (bf16*)(lds + 2 * SHM_V);
  float* ws = (float*)(lds + 2 * SHM_V + 2 * SHM_K) + wid * 64; float* li_l = ws; float* al_l = ws + 32;
  float m_reg = -1e30f, l_reg = 0; f32x16 o[4] = {}; bf16x8 qr[8];
  const TQ* Qw = Qb + (long)(wid * QBLK + r32) * LDQ + hi * 8;
#pragma unroll
  for (int d0 = 0; d0 < 8; ++d0) qr[d0] = SQ::tobf(SQ::ld8(Qw + d0 * 16));
  const int sr = tid >> 4, sc = (tid & 15) * 8, vst0 = v_st(sr, sc), vst1 = v_st(32 + sr, sc);
  const int vb0 = (int)(uintptr_t)V_lds + v_rd_base(lane);
  struct { typename St::T vs0, vs1, ks0, ks1; } sr_[SDEPTH];
#define SLOAD(i, k0) do { sr_[i].vs0 = St::ld8(&Vh[(long)((k0) + sr) * LDK + sc]); sr_[i].vs1 = St::ld8(&Vh[(long)((k0) + 32 + sr) * LDK + sc]); \
    sr_[i].ks0 = St::ld8(&Kh[(long)((k0) + sr) * LDK + sc]); sr_[i].ks1 = St::ld8(&Kh[(long)((k0) + 32 + sr) * LDK + sc]); } while (0)
#define SWRITE(b, i) do { *(bf16x8*)((char*)V_lds + (b) * SHM_V + vst0) = St::tobf(sr_[i].vs0);          \
    *(bf16x8*)((char*)V_lds + (b) * SHM_V + vst1) = St::tobf(sr_[i].vs1); int kc = sc * 2;               \
    *(bf16x8*)((char*)K_lds + (b) * SHM_K + KSWZ(sr, kc)) = St::tobf(sr_[i].ks0);                       \
    *(bf16x8*)((char*)K_lds + (b) * SHM_K + KSWZ(32 + sr, kc)) = St::tobf(sr_[i].ks1); } while (0)
#define SWAIT() do { if constexpr (SDEPTH == 2) asm volatile("s_waitcnt vmcnt(4)" ::: "memory"); else asm volatile("s_waitcnt vmcnt(0)" ::: "memory"); } while (0)
#define RESC(a) do { if (__any((a) < 1.f)) { if (hi == 0) al_l[r32] = (a); asm volatile("s_waitcnt lgkmcnt(0)" ::: "memory"); \
    for (int d = 0; d < 4; ++d) for (int r = 0; r < 16; ++r) o[d][r] *= al_l[crow(r, hi)]; } } while (0)
  f32x16 pA0, pA1, pB0, pB1; float mnA, mnB, alA, alB; bf16x8 pa0, pa1, pa2, pa3; const int NT = seq / KVBLK;
  constexpr int SE = 0, SO = SDEPTH - 1;
  SLOAD(SE, 0); asm volatile("s_waitcnt vmcnt(0)" ::: "memory"); SWRITE(0, SE); __syncthreads();
  qkt(pA0, pA1, K_lds, qr, r32, hi); partialSM(pA0, pA1, m_reg, mnA, alA);
  SLOAD(SO, KVBLK); if constexpr (SDEPTH == 2) { if (2 < NT) SLOAD(SE, 2 * KVBLK); }
  SWAIT(); SWRITE(1, SO); __syncthreads();
  for (int j = 1; j + 1 < NT; j += 2) {
    SBAR(); qkt(pB0, pB1, (bf16*)((char*)K_lds + SHM_K), qr, r32, hi);
    finishSM(pA0, pA1, alA, l_reg, pa0, pa1, pa2, pa3); SBAR();
    SLOAD(SO, (j + SDEPTH) * KVBLK); SBAR();
    pv_d0(o, vb0, pa0, pa1, pa2, pa3); partialSM(pB0, pB1, m_reg, mnB, alB);
    __syncthreads(); SWAIT(); SWRITE(0, SE);
    RESC(alB); __syncthreads();
    SBAR(); qkt(pA0, pA1, K_lds, qr, r32, hi);
    finishSM(pB0, pB1, alB, l_reg, pa0, pa1, pa2, pa3); SBAR();
    if (SDEPTH == 1 || j + 3 < NT) SLOAD(SE, (j + 1 + SDEPTH) * KVBLK); SBAR();
    pv_d0(o, vb0 + (int)SHM_V, pa0, pa1, pa2, pa3); partialSM(pA0, pA1, m_reg, mnA, alA);
    __syncthreads(); SWAIT(); SWRITE(1, SO);
    RESC(alA); __syncthreads();
  }
  SBAR(); qkt(pB0, pB1, (bf16*)((char*)K_lds + SHM_K), qr, r32, hi);
  finishSM(pA0, pA1, alA, l_reg, pa0, pa1, pa2, pa3); SBAR();
  pv_d0(o, vb0, pa0, pa1, pa2, pa3); partialSM(pB0, pB1, m_reg, mnB, alB);
  __syncthreads(); RESC(alB);
  finishSM(pB0, pB1, alB, l_reg, pa0, pa1, pa2, pa3); SBAR();
  pv_d0(o, vb0 + (int)SHM_V, pa0, pa1, pa2, pa3);
  if (hi == 0) li_l[r32] = l_reg; asm volatile("s_waitcnt lgkmcnt(0)" ::: "memory");
  float rli[16];
#pragma unroll
  for (int r = 0; r < 16; ++r) rli[r] = __builtin_amdgcn_rcpf(li_l[crow(r, hi)]);
  unsigned short* Ow = Ob + (long)(wid * QBLK) * LDO;
#pragma unroll
  for (int r = 0; r < 16; ++r) { int orow = crow(r, hi);
    for (int d0 = 0; d0 < 4; ++d0) Ow[(long)orow * LDO + d0 * 32 + r32] = (unsigned short)(cvtpk(o[d0][r] * rli[r], 0.f) & 0xffffu); }
#undef SLOAD
#undef SWRITE
#undef SWAIT
#undef RESC
}
}

#define LAS __attribute__((address_space(3)))
typedef unsigned short u16;
typedef short bf16x8 __attribute__((ext_vector_type(8)));
typedef float f32x4 __attribute__((ext_vector_type(4)));
typedef float f32x16 __attribute__((ext_vector_type(16)));
typedef unsigned u32x4 __attribute__((ext_vector_type(4)));
typedef unsigned u32x2 __attribute__((ext_vector_type(2)));

constexpr int M = 12288, MP = 4096, DM = 1024, FF = 2816, NMOD = 9216;
constexpr size_t HM = 524288;
constexpr size_t WS_MOD = 0, WS_ROPE = 262144, WS_AB = 2 * HM, WS_GC = 6 * HM;
constexpr size_t WS_WIN11 = 8 * HM, WS_WOUT11 = 30 * HM, WS_WDNO = 41 * HM, WS_WDNIN = 45 * HM, WS_WIN10 = 62 * HM, WS_WOUT10 = 84 * HM;
constexpr size_t WS_WIN00 = 95 * HM, WS_WIN01 = 117 * HM, WS_WOUT00 = 139 * HM, WS_WOUT01 = 150 * HM, WS_WQKV = 161 * HM, WS_WO = 167 * HM;
constexpr size_t WS_XN = 171 * HM, WS_BIG = 219 * HM;
constexpr size_t WS_G = WS_BIG;
constexpr size_t WS_Q = WS_BIG, WS_O = WS_BIG + 48 * HM, WS_KB = WS_BIG + 96 * HM, WS_VB = WS_BIG + 110 * HM;
constexpr size_t WS_QKVR = WS_BIG, WS_Z = WS_BIG + 144 * HM, WS_U = WS_BIG + 192 * HM, WS_QN = WS_BIG + 288 * HM, WS_W = 62 * HM, WS_KN = 158 * HM;
constexpr size_t WS_OF = WS_BIG + 48 * HM, WS_OB = WS_BIG + 96 * HM, WS_O2 = WS_BIG;
constexpr size_t WS_END = WS_QN + 48 * HM;
constexpr int OUT_NK = 12582912, OUT_NV = 13631488, OUT_SF = 14680064, OUT_SB = 16777216;
constexpr int LDS_BYTES = 147456, LDS_RED = 131072, LDS_BARST = 147392;
constexpr size_t WS_CTL = 524288, CTL_BYTES = 131072;
constexpr size_t WS_XBUF = 786432;

struct Params { const float* in[30]; float* out; unsigned char* ws; };

__device__ __forceinline__ unsigned cvtpk(float lo, float hi) { return cvtpk_rne(lo, hi); }
__device__ __forceinline__ u16 f2bf(float f) { return (u16)(cvtpk(f, 0.f) & 0xffffu); }
__device__ __forceinline__ float bflo(unsigned w) { return __uint_as_float(w << 16); }
__device__ __forceinline__ float bfhi(unsigned w) { return __uint_as_float(w & 0xffff0000u); }
__device__ __forceinline__ float silu(float x) { return x * __builtin_amdgcn_rcpf(1.0f + __expf(-x)); }
__device__ __forceinline__ float wave_sum(float v) {
#pragma unroll
    for (int o = 1; o < 64; o <<= 1) v += __shfl_xor(v, o);
    return v;
}
__device__ __forceinline__ int crow(int r, int hi) { return (r & 3) + 8 * (r >> 2) + 4 * hi; }
template <int KSTEPS> __device__ __forceinline__ void mm_tile(f32x16& acc, const LAS char* A, int sA, const LAS char* Bt, int sB, int r32, int hi) {
    bf16x8 a[KSTEPS], b[KSTEPS];
#pragma unroll
    for (int ks = 0; ks < KSTEPS; ++ks) { a[ks] = *(const LAS bf16x8*)(A + r32 * sA + (ks * 16 + hi * 8) * 2); b[ks] = *(const LAS bf16x8*)(Bt + r32 * sB + (ks * 16 + hi * 8) * 2); }
#pragma unroll
    for (int ks = 0; ks < KSTEPS; ++ks) acc = __builtin_amdgcn_mfma_f32_32x32x16_bf16(a[ks], b[ks], acc, 0, 0, 0);
}

__device__ __forceinline__ int map_col(int mode, int r) {
    if (mode == 1) { const int pn = r >> 8, w = r & 255; return w < 128 ? pn * 128 + w : FF + pn * 128 + (w - 128); }
    if (mode == 2) { if (r < 1280) { const int b4 = (r >> 4) & 1, b5 = (r >> 5) & 1; return (r & ~48) | (b4 << 5) | (b5 << 4); } return r; }
    return r;
}
__device__ __forceinline__ void transpose_item(const float* W, int K, int Nsrc, u16* WT, int mode, LAS float* scr, int item, int nblk, int lane) {
    const int kb = item / nblk, nb = item % nblk, k0 = 64 * kb, n0 = 64 * nb;
    const int r = lane >> 4, cg = lane & 15, sc = map_col(mode, n0 + 4 * cg);
#pragma unroll 8
    for (int i = 0; i < 16; ++i) { const int kk = 4 * i + r; const f32x4 v = __builtin_nontemporal_load((const f32x4*)(W + (size_t)(k0 + kk) * Nsrc + sc));
        LAS float* d = scr + kk * 65 + 4 * cg; d[0] = v[0]; d[1] = v[1]; d[2] = v[2]; d[3] = v[3]; }
    asm volatile("s_waitcnt lgkmcnt(0)" ::: "memory");
    const int c = lane & 7;
#pragma unroll
    for (int j = 0; j < 8; ++j) { const int n = (lane >> 3) + 8 * j; const LAS float* s = scr + (8 * c) * 65 + n;
        u32x4 o; o.x = cvtpk(s[0 * 65], s[1 * 65]); o.y = cvtpk(s[2 * 65], s[3 * 65]); o.z = cvtpk(s[4 * 65], s[5 * 65]); o.w = cvtpk(s[6 * 65], s[7 * 65]);
        *(u32x4*)(WT + (size_t)(n0 + n) * K + k0 + 8 * c) = o; }
    asm volatile("s_waitcnt lgkmcnt(0)" ::: "memory");
}
__device__ __forceinline__ int seg_items(int sgm) { return (sgm == 0 || sgm == 4 || sgm == 8 || sgm == 10) ? 1408 : (sgm == 1 || sgm == 5 || sgm == 9 || sgm == 11) ? 704 : sgm == 2 ? 384 : sgm == 6 ? 1024 : 256; }
__device__ __forceinline__ void seg_item(const Params& P, int sgm, int r, LAS float* scr, int lane) {
    unsigned char* ws = P.ws;
    switch (sgm) {
        case 0:  transpose_item(P.in[11], DM, 2 * FF, (u16*)(ws + WS_WIN00), 1, scr, r, 88, lane); break;
        case 1:  transpose_item(P.in[12], FF, DM, (u16*)(ws + WS_WOUT00), 0, scr, r, 16, lane); break;
        case 2:  transpose_item(P.in[14], DM, 1536, (u16*)(ws + WS_WQKV), 2, scr, r, 24, lane); break;
        case 3:  transpose_item(P.in[17], DM, DM, (u16*)(ws + WS_WO), 0, scr, r, 16, lane); break;
        case 4:  transpose_item(P.in[27], DM, 2 * FF, (u16*)(ws + WS_WIN01), 1, scr, r, 88, lane); break;
        case 5:  transpose_item(P.in[28], FF, DM, (u16*)(ws + WS_WOUT01), 0, scr, r, 16, lane); break;
        case 6:  transpose_item(P.in[18], DM, 4096, (u16*)(ws + WS_WDNIN), 0, scr, r, 64, lane); break;
        case 7:  transpose_item(P.in[25], DM, DM, (u16*)(ws + WS_WDNO), 0, scr, r, 16, lane); break;
        case 8:  transpose_item(P.in[11] + (size_t)DM * 2 * FF, DM, 2 * FF, (u16*)(ws + WS_WIN10), 1, scr, r, 88, lane); break;
        case 9:  transpose_item(P.in[12] + (size_t)FF * DM, FF, DM, (u16*)(ws + WS_WOUT10), 0, scr, r, 16, lane); break;
        case 10: transpose_item(P.in[27] + (size_t)DM * 2 * FF, DM, 2 * FF, (u16*)(ws + WS_WIN11), 1, scr, r, 88, lane); break;
        default: transpose_item(P.in[28] + (size_t)FF * DM, FF, DM, (u16*)(ws + WS_WOUT11), 0, scr, r, 16, lane); break;
    }
}
__device__ __forceinline__ void copy_items_range(const Params& P, LAS char* lds, int seg0, int it_lo, int it_hi, int worker, int nworkers, int lane, int wid) {
    LAS float* scr = (LAS float*)(lds + wid * 16640);
    for (int it = it_lo + worker; it < it_hi; it += nworkers) { int r = it, sgm = seg0;
        while (r >= seg_items(sgm)) { r -= seg_items(sgm); ++sgm; }
        seg_item(P, sgm, r, scr, lane); }
}
__device__ __forceinline__ void copy_items(const Params& P, LAS char* lds, int seg0, int seg1, int first_wg, int wv) {
    if ((int)blockIdx.x < first_wg) return;
    const int tid = ltid(wv), lane = tid & 63, wid = tid >> 6; int n = 0;
    for (int sgm = seg0; sgm < seg1; ++sgm) n += seg_items(sgm);
    copy_items_range(P, lds, seg0, 0, n, ((int)blockIdx.x - first_wg) * 8 + wid, ((int)gridDim.x - first_wg) * 8, lane, wid);
}
__device__ __forceinline__ void phase0(const Params& P, LAS char* lds, int wv) {
    const int tid = ltid(wv), lane = tid & 63, wid = tid >> 6, G = gridDim.x;
    unsigned char* ws = P.ws;
    if ((int)blockIdx.x < 144 || G < 144) {
      LAS float* sc = (LAS float*)lds;
      LAS float* red = (LAS float*)(lds + 16384);
      for (int i = tid; i < 3072; i += 512) { const int cnd = i >> 10, k = i & 1023; const float v = cnd == 0 ? P.in[7][k] : P.in[6][(cnd - 1) * 1024 + k]; sc[i] = silu(v); }
      __syncthreads();
      float* MOD = (float*)(ws + WS_MOD);
      for (int it = blockIdx.x; it < 144; it += G) {
          const int l = it / 72, cb = it % 72, cg = tid & 31, kp = tid >> 5;
          const float* W = P.in[8] + (size_t)l * DM * NMOD + cb * 128 + cg * 4;
          f32x4 a0 = {0.f, 0.f, 0.f, 0.f}, a1 = a0, a2 = a0;
#pragma unroll 16
          for (int k = kp * 64; k < kp * 64 + 64; ++k) { const f32x4 w = __builtin_nontemporal_load((const f32x4*)(W + (size_t)k * NMOD)); a0 += w * sc[k]; a1 += w * sc[1024 + k]; a2 += w * sc[2048 + k]; }
          LAS float* rp = red + (kp * 32 + cg) * 12;
#pragma unroll
          for (int j = 0; j < 4; ++j) { rp[j] = a0[j]; rp[4 + j] = a1[j]; rp[8 + j] = a2[j]; }
          __syncthreads();
          if (tid < 384) { const int c2 = tid & 127, cnd = tid >> 7; float s = P.in[9][l * NMOD + cb * 128 + c2];
#pragma unroll
              for (int q = 0; q < 16; ++q) s += red[(q * 32 + (c2 >> 2)) * 12 + cnd * 4 + (c2 & 3)];
              MOD[(l * 3 + cnd) * NMOD + cb * 128 + c2] = s; }
          __syncthreads();
      } }
    __syncthreads();
    {   const bool gemvwg = (int)blockIdx.x < 144 && G == 256;
        constexpr int NI = 1408 + 704, NSPLIT = NI;
        if (G == 256) { if (gemvwg) copy_items_range(P, lds, 0, NSPLIT, NI, (int)blockIdx.x * 8 + wid, 144 * 8, lane, wid); else copy_items_range(P, lds, 0, 0, NSPLIT, ((int)blockIdx.x - 144) * 8 + wid, 112 * 8, lane, wid); }
        else copy_items_range(P, lds, 0, 0, NI, (int)blockIdx.x * 8 + wid, G * 8, lane, wid);
    }
    { u16* WT = (u16*)(ws + WS_WDNIN); const float* wa = P.in[20]; const float* wb = P.in[23];
      for (int idx = blockIdx.x * 512 + tid; idx < 256 * 1024; idx += G * 512) {
          const int rr = idx >> 10, k = idx & 1023; float v = 0.f;
          if (rr < 16) v = wa[((rr >> 3) * 1024 + k) * 8 + (rr & 7)]; else if (rr < 32) v = wb[(((rr - 16) >> 3) * 1024 + k) * 8 + (rr & 7)];
          WT[(size_t)(4096 + rr) * 1024 + k] = f2bf(v); } }
    if (blockIdx.x == G - 1) { float* rope = (float*)(ws + WS_ROPE);
        for (int idx = tid; idx < 2048; idx += 512) { const int pos = idx >> 5, f = idx & 31;
            const float inv = exp2f(-(float)f * (13.287712379549449f / 32.0f)); const float ang = (float)pos * inv;
            rope[idx] = cosf(ang); rope[2048 + idx] = sinf(ang); } }
}

template <bool FIRST> __device__ __forceinline__ void normmod_phase(const Params& P, const float* gain, const float* modl, int ishift, int iscale, int wv) {
    const int lane = ltid(wv) & 63, gw = blockIdx.x * 8 + (ltid(wv) >> 6), NGW = gridDim.x * 8;
    u16* XN = (u16*)(P.ws + WS_XN); float* h = P.out;
    f32x4 gv[4];
#pragma unroll
    for (int j = 0; j < 4; ++j) gv[j] = *(const f32x4*)(gain + 4 * lane + 256 * j);
    for (int row = gw; row < M; row += NGW) {
        const float* src = FIRST ? (row < MP ? P.in[0] + (size_t)row * DM : P.in[1] + (size_t)(row - MP) * DM) : h + (size_t)row * DM;
        const int cond = row < MP ? 0 : (row < MP + 4096 ? 1 : 2);
        const float* sh = modl + cond * NMOD + ishift * 1024, * scl = modl + cond * NMOD + iscale * 1024;
        f32x4 v[4]; float s = 0.f;
#pragma unroll
        for (int j = 0; j < 4; ++j) { v[j] = *(const f32x4*)(src + 4 * lane + 256 * j); s += (v[j][0] * v[j][0] + v[j][1] * v[j][1]) + (v[j][2] * v[j][2] + v[j][3] * v[j][3]); }
        const float rinv = 1.0f / sqrtf(wave_sum(s) * (1.0f / DM) + 1e-6f);
#pragma unroll
        for (int j = 0; j < 4; ++j) {
            if (FIRST) *(f32x4*)(h + (size_t)row * DM + 4 * lane + 256 * j) = v[j];
            const f32x4 sv = *(const f32x4*)(sh + 4 * lane + 256 * j), cv = *(const f32x4*)(scl + 4 * lane + 256 * j);
            const f32x4 y = v[j] * rinv * gv[j] * (cv + 1.0f) + sv;
            u32x2 w; w.x = cvtpk(y[0], y[1]); w.y = cvtpk(y[2], y[3]);
            *(u32x2*)(XN + (size_t)row * DM + 4 * lane + 256 * j) = w;
        }
    }
}
__device__ __forceinline__ void final_norm_phase(const Params& P, int wv) {
    const int lane = ltid(wv) & 63, gw = blockIdx.x * 8 + (ltid(wv) >> 6), NGW = gridDim.x * 8;
    float* h = P.out; const float* gain = P.in[29];
    f32x4 gv[4];
#pragma unroll
    for (int j = 0; j < 4; ++j) gv[j] = *(const f32x4*)(gain + 4 * lane + 256 * j);
    for (int row = gw; row < M; row += NGW) {
        float* src = h + (size_t)row * DM; f32x4 v[4]; float s = 0.f;
#pragma unroll
        for (int j = 0; j < 4; ++j) { v[j] = *(const f32x4*)(src + 4 * lane + 256 * j); s += (v[j][0] * v[j][0] + v[j][1] * v[j][1]) + (v[j][2] * v[j][2] + v[j][3] * v[j][3]); }
        const float rinv = 1.0f / sqrtf(wave_sum(s) * (1.0f / DM) + 1e-6f);
#pragma unroll
        for (int j = 0; j < 4; ++j) *(f32x4*)(src + 4 * lane + 256 * j) = v[j] * rinv * gv[j];
    }
}
__device__ __forceinline__ void cache_copy(const Params& P, int wv) {
    u16* KB = (u16*)(P.ws + WS_KB); u16* VB = (u16*)(P.ws + WS_VB);
    for (int i = blockIdx.x * 512 + ltid(wv); i < 2 * 2 * 512 * 64; i += gridDim.x * 512) {
        const int which = i >> 16, j = i & 65535, b = j >> 15, rem = j & 32767;
        const f32x4 v = *(const f32x4*)(P.in[which ? 3 : 2] + (size_t)b * 131072 + rem * 4);
        u32x2 w; w.x = cvtpk(v[0], v[1]); w.y = cvtpk(v[2], v[3]);
        *(u32x2*)((which ? VB : KB) + (size_t)(4096 + b * 4608) * 256 + rem * 4) = w;
    }
}

__device__ __forceinline__ void attn_phase(const Params& P, char* lds, int wv) {
    const att::bf16* Q = (const att::bf16*)(P.ws + WS_Q); const att::bf16* KB = (const att::bf16*)(P.ws + WS_KB); const att::bf16* VB = (const att::bf16*)(P.ws + WS_VB);
    u16* O = (u16*)(P.ws + WS_O);
    for (int u = blockIdx.x; u < 384; u += gridDim.x) {
        size_t qrow, krow; int head, kvh, seq;
        if (u < 256) { const int x = u & 7, i = u >> 3, pair = x >> 1, b = pair >> 1, sub = (x & 1) * 32 + i, qb = sub & 15; kvh = pair & 1; head = kvh * 4 + (sub >> 4);
            qrow = 4096 + (size_t)b * 4096 + qb * 256; krow = 4096 + (size_t)b * 4608; seq = 4608; }
        else { const int v = u - 256, b = v >> 3; head = v & 7; kvh = head >> 2; qrow = (size_t)b * 256; krow = qrow; seq = 256; }
        att::attn_dense_body<att::bf16>(Q + qrow * 1024 + head * 128, KB + krow * 256 + kvh * 128, VB + krow * 256 + kvh * 128, O + qrow * 1024 + head * 128, seq, lds, wv);
        __syncthreads();
    }
}

__device__ __forceinline__ void ab_tile_phase(const Params& P, LAS char* lds, int wv) {
    const int tid = ltid(wv), lane = tid & 63, wid = tid >> 6, r32 = lane & 31, hi = lane >> 5;
    const u16* XN = (const u16*)(P.ws + WS_XN); const u16* WT = (const u16*)(P.ws + WS_WDNIN) + (size_t)4096 * 1024; float* AB = (float*)(P.ws + WS_AB);
    LAS float* red = (LAS float*)lds;
    for (int blk = blockIdx.x; blk < 192; blk += gridDim.x) {
        const int row0 = blk * 64;
        f32x16 acc0 = {}, acc1 = {};
        bf16x8 a0[8], a1[8], b[8];
#pragma unroll
        for (int ks = 0; ks < 8; ++ks) { const int k = (wid * 8 + ks) * 16 + hi * 8;
            b[ks] = *(const bf16x8*)(WT + (size_t)r32 * 1024 + k);
            a0[ks] = *(const bf16x8*)(XN + (size_t)(row0 + r32) * 1024 + k); a1[ks] = *(const bf16x8*)(XN + (size_t)(row0 + 32 + r32) * 1024 + k); }
#pragma unroll
        for (int ks = 0; ks < 8; ++ks) { acc0 = __builtin_amdgcn_mfma_f32_32x32x16_bf16(a0[ks], b[ks], acc0, 0, 0, 0); acc1 = __builtin_amdgcn_mfma_f32_32x32x16_bf16(a1[ks], b[ks], acc1, 0, 0, 0); }
#pragma unroll
        for (int r = 0; r < 16; ++r) { red[((wid * 2 + 0) * 16 + r) * 64 + lane] = acc0[r]; red[((wid * 2 + 1) * 16 + r) * 64 + lane] = acc1[r]; }
        __syncthreads();
        for (int o = tid; o < 2048; o += 512) { float s = 0.f;
#pragma unroll
            for (int w = 0; w < 8; ++w) s += red[w * 2048 + o];
            const int mt = o >> 10, r = (o >> 6) & 15, l = o & 63;
            AB[(size_t)(row0 + mt * 32 + crow(r, l >> 5)) * 32 + (l & 31)] = s; }
        __syncthreads();
    }
}

__device__ __forceinline__ void conv8(const u16* p, bool hasPrev, bool hasNext, const float* cw, float (&out)[8]) {
    const u32x4 z = {0u, 0u, 0u, 0u};
    const u32x4 xc = *(const u32x4*)p, xp = hasPrev ? *(const u32x4*)(p - 3072) : z, xn = hasNext ? *(const u32x4*)(p + 3072) : z;
    const f32x4 w0a = *(const f32x4*)cw, w0b = *(const f32x4*)(cw + 4), w1a = *(const f32x4*)(cw + 3072), w1b = *(const f32x4*)(cw + 3076), w2a = *(const f32x4*)(cw + 6144), w2b = *(const f32x4*)(cw + 6148);
#pragma unroll
    for (int i = 0; i < 4; ++i) {
        const float w0l = i < 2 ? w0a[2 * i] : w0b[2 * i - 4], w0h = i < 2 ? w0a[2 * i + 1] : w0b[2 * i - 3];
        const float w1l = i < 2 ? w1a[2 * i] : w1b[2 * i - 4], w1h = i < 2 ? w1a[2 * i + 1] : w1b[2 * i - 3];
        const float w2l = i < 2 ? w2a[2 * i] : w2b[2 * i - 4], w2h = i < 2 ? w2a[2 * i + 1] : w2b[2 * i - 3];
        out[2 * i] = silu(bflo(xp[i]) * w0l + bflo(xc[i]) * w1l + bflo(xn[i]) * w2l);
        out[2 * i + 1] = silu(bfhi(xp[i]) * w0h + bfhi(xc[i]) * w1h + bfhi(xn[i]) * w2h);
    }
}
constexpr int D1_K = 0, D1_KT = 17408, D1_VT = 35840, D1_A0 = 54272, D1_A1 = 71680, D1_T = 89088, D1_GC = 125952;
__device__ __forceinline__ void d1_task(const Params& P, int ch, int h, LAS char* lds, int wv) {
    const int tid = ltid(wv), lane = tid & 63, wid = tid >> 6, r32 = lane & 31, hi = lane >> 5;
    unsigned char* ws = P.ws;
    const u16* QKVR = (const u16*)(ws + WS_QKVR); const float* AB = (const float*)(ws + WS_AB); float* GC = (float*)(ws + WS_GC);
    u16* QN = (u16*)(ws + WS_QN); u16* KN = (u16*)(ws + WS_KN); u16* U = (u16*)(ws + WS_U); u16* W = (u16*)(ws + WS_W);
    LAS char* Kl = lds + D1_K; LAS char* KTl = lds + D1_KT; LAS char* VTl = lds + D1_VT;
    LAS float* A0f = (LAS float*)(lds + D1_A0); LAS float* A1f = (LAS float*)(lds + D1_A1); LAS char* Tl = lds + D1_T;
    LAS float* gcl = (LAS float*)(lds + D1_GC); LAS float* betal = gcl + 128;
    const int r0 = ch * 64, seqlen = r0 < MP ? 256 : 4096;
    float ab_a = 0.f, ab_b = 0.f, dtb = 0.f, alg = 0.f;
    if (wid < 2) { const int row = r0 + lane; ab_a = AB[(size_t)row * 32 + wid * 8 + h]; ab_b = AB[(size_t)row * 32 + 16 + wid * 8 + h]; dtb = P.in[21][wid * 8 + h]; alg = P.in[22][wid * 8 + h]; }
    {
        const int c = tid >> 3, grp = tid & 7, row = r0 + c;
        const bool hasPrev = (row % seqlen) != 0, hasNext = ((row + 1) % seqlen) != 0;
        const u16* p = QKVR + (size_t)row * 3072 + h * 128 + grp * 16; const float* cw = P.in[19] + h * 128 + grp * 16;
        float qa[8], qb[8], ka[8], kb[8], va[8], vb[8];
        conv8(p, hasPrev, hasNext, cw, qa); conv8(p + 8, hasPrev, hasNext, cw + 8, qb);
        conv8(p + 1024, hasPrev, hasNext, cw + 1024, ka); conv8(p + 1032, hasPrev, hasNext, cw + 1032, kb);
        conv8(p + 2048, hasPrev, hasNext, cw + 2048, va); conv8(p + 2056, hasPrev, hasNext, cw + 2056, vb);
        float sq = 0.f, sk = 0.f;
#pragma unroll
        for (int i = 0; i < 8; ++i) { sq += qa[i] * qa[i] + qb[i] * qb[i]; sk += ka[i] * ka[i] + kb[i] * kb[i]; }
        sq += __shfl_xor(sq, 1); sq += __shfl_xor(sq, 2); sq += __shfl_xor(sq, 4);
        sk += __shfl_xor(sk, 1); sk += __shfl_xor(sk, 2); sk += __shfl_xor(sk, 4);
        const float rq = 0.088388347648318440f / sqrtf(sq + 1e-6f), rk = 1.0f / sqrtf(sk + 1e-6f);
        u32x4 q0, q1, w0, w1;
        q0.x = cvtpk(qa[0] * rq, qa[1] * rq); q0.y = cvtpk(qa[2] * rq, qa[3] * rq); q0.z = cvtpk(qa[4] * rq, qa[5] * rq); q0.w = cvtpk(qa[6] * rq, qa[7] * rq);
        q1.x = cvtpk(qb[0] * rq, qb[1] * rq); q1.y = cvtpk(qb[2] * rq, qb[3] * rq); q1.z = cvtpk(qb[4] * rq, qb[5] * rq); q1.w = cvtpk(qb[6] * rq, qb[7] * rq);
        w0.x = cvtpk(ka[0] * rk, ka[1] * rk); w0.y = cvtpk(ka[2] * rk, ka[3] * rk); w0.z = cvtpk(ka[4] * rk, ka[5] * rk); w0.w = cvtpk(ka[6] * rk, ka[7] * rk);
        w1.x = cvtpk(kb[0] * rk, kb[1] * rk); w1.y = cvtpk(kb[2] * rk, kb[3] * rk); w1.z = cvtpk(kb[4] * rk, kb[5] * rk); w1.w = cvtpk(kb[6] * rk, kb[7] * rk);
        { u16* dst = QN + (size_t)row * 1024 + h * 128 + grp * 16; *(u32x4*)dst = q0; *(u32x4*)(dst + 8) = q1; }
        { u16* dst = KN + (size_t)row * 1024 + h * 128 + grp * 16; *(u32x4*)dst = w0; *(u32x4*)(dst + 8) = w1; }
        *(LAS u32x4*)(Kl + c * 272 + grp * 32) = w0; *(LAS u32x4*)(Kl + c * 272 + grp * 32 + 16) = w1;
#pragma unroll
        for (int i = 0; i < 4; ++i) {
            *(LAS u16*)(KTl + (grp * 16 + 2 * i) * 144 + c * 2) = (u16)(w0[i] & 0xffffu); *(LAS u16*)(KTl + (grp * 16 + 2 * i + 1) * 144 + c * 2) = (u16)(w0[i] >> 16);
            *(LAS u16*)(KTl + (grp * 16 + 8 + 2 * i) * 144 + c * 2) = (u16)(w1[i] & 0xffffu); *(LAS u16*)(KTl + (grp * 16 + 9 + 2 * i) * 144 + c * 2) = (u16)(w1[i] >> 16); }
#pragma unroll
        for (int i = 0; i < 8; ++i) { *(LAS u16*)(VTl + (grp * 16 + i) * 144 + c * 2) = f2bf(va[i]); *(LAS u16*)(VTl + (grp * 16 + 8 + i) * 144 + c * 2) = f2bf(vb[i]); }
    }
    if (wid < 2) {
        const int dir = wid, c = lane, row = r0 + c;
        const float av = ab_a + dtb;
        const float sp = av > 20.f ? av : log1pf(expf(av));
        const float g = -expf(alg) * sp;
        const float bt = 1.0f / (1.0f + expf(-ab_b));
        float s = g;
#pragma unroll
        for (int off = 1; off < 64; off <<= 1) {
            const float t = dir == 0 ? __shfl_up(s, off) : __shfl_down(s, off);
            const bool ok = dir == 0 ? (lane >= off) : (lane + off < 64);
            if (ok) s += t;
        }
        gcl[dir * 64 + c] = s; betal[dir * 64 + c] = bt; GC[((size_t)dir * M + row) * 8 + h] = s;
    }
    __syncthreads();
    if (wid < 4) {
        const int mt = wid >> 1, nt = wid & 1; f32x16 acc = {};
        mm_tile<8>(acc, Kl + mt * 32 * 272, 272, Kl + nt * 32 * 272, 272, r32, hi);
        const int s = nt * 32 + r32; const float gs0 = gcl[s], gs1 = gcl[64 + s]; float g0v[16], g1v[16], b0v[16], b1v[16];
#pragma unroll
        for (int r = 0; r < 16; ++r) { const int c = mt * 32 + crow(r, hi); g0v[r] = gcl[c]; g1v[r] = gcl[64 + c]; b0v[r] = betal[c]; b1v[r] = betal[64 + c]; }
#pragma unroll
        for (int r = 0; r < 16; ++r) { const int c = mt * 32 + crow(r, hi); const float kk = acc[r];
            const float a0 = (c > s) ? b0v[r] * kk * __expf(fminf(g0v[r] - gs0, 0.f)) : 0.f;
            const float a1 = (c < s) ? b1v[r] * kk * __expf(fminf(g1v[r] - gs1, 0.f)) : 0.f;
            A0f[c * 68 + s] = a0; A1f[(63 - c) * 68 + (63 - s)] = a1; }
    }
    __syncthreads();
    if (wid < 2) {
        const int dir = wid, j = lane; LAS float* Af = dir ? A1f : A0f;
        for (int ib = 0; ib < 8; ++ib) {
            float s[8];
#pragma unroll
            for (int r = 0; r < 8; ++r) s[r] = (8 * ib + r == j) ? 1.f : 0.f;
#pragma unroll 2
            for (int m2 = 0; m2 < 8 * ib; m2 += 4) {
                const float x0 = Af[(m2 + 0) * 68 + j], x1 = Af[(m2 + 1) * 68 + j], x2 = Af[(m2 + 2) * 68 + j], x3 = Af[(m2 + 3) * 68 + j];
#pragma unroll
                for (int r = 0; r < 8; ++r) { const f32x4 a = *(const LAS f32x4*)(Af + (8 * ib + r) * 68 + m2); s[r] -= (a[0] * x0 + a[1] * x1) + (a[2] * x2 + a[3] * x3); }
            }
            f32x4 dl[8], dh[8];
#pragma unroll
            for (int r = 0; r < 8; ++r) { dl[r] = *(const LAS f32x4*)(Af + (8 * ib + r) * 68 + 8 * ib); dh[r] = *(const LAS f32x4*)(Af + (8 * ib + r) * 68 + 8 * ib + 4); }
#pragma unroll
            for (int r = 1; r < 8; ++r) {
#pragma unroll
                for (int q = 0; q < r; ++q) s[r] -= (q < 4 ? dl[r][q] : dh[r][q - 4]) * s[q];
            }
            asm volatile("s_waitcnt lgkmcnt(0)" ::: "memory");
#pragma unroll
            for (int r = 0; r < 8; ++r) Af[(8 * ib + r) * 68 + j] = s[r];
        }
    }
    __syncthreads();
    {
#pragma unroll 4
        for (int k = 0; k < 16; ++k) { const int idx = tid + 512 * k, dir = idx >> 12, c = (idx >> 6) & 63, s = idx & 63;
            const float t = dir ? A1f[(63 - c) * 68 + (63 - s)] : A0f[c * 68 + s];
            const float bs = betal[dir * 64 + s], bgs = bs * __expf(gcl[dir * 64 + s]);
            *(LAS u16*)(Tl + (dir * 2) * 9216 + c * 144 + s * 2) = f2bf(t * bs); *(LAS u16*)(Tl + (dir * 2 + 1) * 9216 + c * 144 + s * 2) = f2bf(t * bgs); }
    }
    __syncthreads();
    {
        const int dir = wid >> 2, kind = (wid >> 1) & 1, tbase = (wid & 1) * 4;
        const LAS char* Aop = kind ? KTl : VTl; const LAS char* Bop = Tl + (dir * 2 + kind) * 9216;
        const size_t tb = ((size_t)dir * 192 + ch) * 8 + h;
#pragma unroll
        for (int t = 0; t < 4; ++t) { const int tile = tbase + t, mt = tile >> 1, nt = tile & 1; f32x16 acc = {};
            mm_tile<4>(acc, Aop + mt * 32 * 144, 144, Bop + nt * 32 * 144, 144, r32, hi);
            if (kind == 0) { u16* dst = U + ((tb * 8 + tile) * 64 + lane) * 16; u32x4 w0, w1;
                w0.x = cvtpk(acc[0], acc[1]); w0.y = cvtpk(acc[2], acc[3]); w0.z = cvtpk(acc[4], acc[5]); w0.w = cvtpk(acc[6], acc[7]);
                w1.x = cvtpk(acc[8], acc[9]); w1.y = cvtpk(acc[10], acc[11]); w1.z = cvtpk(acc[12], acc[13]); w1.w = cvtpk(acc[14], acc[15]);
                *(u32x4*)dst = w0; *(u32x4*)(dst + 8) = w1; }
            else { const int c = nt * 32 + r32; u16* dst = W + (tb * 64 + c) * 128 + mt * 32 + 4 * hi;
#pragma unroll
                for (int q = 0; q < 4; ++q) { u32x2 w; w.x = cvtpk(acc[4 * q], acc[4 * q + 1]); w.y = cvtpk(acc[4 * q + 2], acc[4 * q + 3]); *(u32x2*)(dst + 8 * q) = w; } }
        }
    }
    __syncthreads();
}

constexpr int D2_ST = 0, D2_W = 17408, D2_Q = 34816, D2_K = 52224, D2_KT = 69632, D2_VN = 88064, D2_VN2 = 97280, D2_QK = 106496, D2_GC = 115712, D2_KT2OFF = 116224 - 69632;
__device__ __forceinline__ void d2_chain(const Params& P, int seq, int h, int dir, int vh, LAS char* lds, int wv) {
    const int tid = ltid(wv), lane = tid & 63, wid = tid >> 6, r32 = lane & 31, hi = lane >> 5;
    unsigned char* ws = P.ws;
    const u16* QN = (const u16*)(ws + WS_QN); const u16* KN = (const u16*)(ws + WS_KN); const u16* U = (const u16*)(ws + WS_U); const u16* W = (const u16*)(ws + WS_W);
    const float* GC = (const float*)(ws + WS_GC); u16* OX = (u16*)(ws + (dir ? WS_OB : WS_OF));
    LAS char* STl = lds + D2_ST; LAS char* Wl = lds + D2_W; LAS char* Ql = lds + D2_Q; LAS char* Kl = lds + D2_K; LAS char* KTl = lds + D2_KT;
    LAS char* VNl = lds + D2_VN; LAS char* VN2l = lds + D2_VN2; LAS char* QKl = lds + D2_QK; LAS float* gcl = (LAS float*)(lds + D2_GC);
    const bool samp = seq >= 16; const int rbase = samp ? MP + (seq - 16) * 4096 : seq * 256, nch = samp ? 64 : 4, ch0 = rbase >> 6;
    const int mtS = wid >> 2, ntS = wid & 3;
    const int mtl = (wid >> 1) & 1, ntc = wid & 1;
    f32x16 accS = {};
    if (samp) { const float* st = P.in[dir ? 5 : 4] + ((size_t)((seq - 16) * 8 + h) * 128) * 128 + (size_t)(ntS * 32 + r32) * 128 + vh * 64 + mtS * 32 + 4 * hi;
#pragma unroll
        for (int q = 0; q < 4; ++q) { const f32x4 t = *(const f32x4*)(st + 8 * q); accS[4 * q] = t[0]; accS[4 * q + 1] = t[1]; accS[4 * q + 2] = t[2]; accS[4 * q + 3] = t[3]; } }
    const int sc = tid >> 3, sg = tid & 7;
    u32x4 pq0, pq1, pk0, pk1, pw0, pw1, pu0 = {}, pu1 = {}; float pgc = 0.f;
#define D2_LOAD(n_) do { const int ch_ = ch0 + (dir ? nch - 1 - (n_) : (n_)); const size_t row_ = (size_t)ch_ * 64 + sc; \
        const u16* qp_ = QN + row_ * 1024 + h * 128 + sg * 16; pq0 = *(const u32x4*)qp_; pq1 = *(const u32x4*)(qp_ + 8); \
        const u16* kp_ = KN + row_ * 1024 + h * 128 + sg * 16; pk0 = *(const u32x4*)kp_; pk1 = *(const u32x4*)(kp_ + 8); \
        const size_t tb_ = ((size_t)dir * 192 + ch_) * 8 + h; \
        const u16* wp_ = W + (tb_ * 64 + sc) * 128 + sg * 16; pw0 = *(const u32x4*)wp_; pw1 = *(const u32x4*)(wp_ + 8); \
        if (wid < 4) { const u16* up_ = U + ((tb_ * 8 + (vh * 2 + mtl) * 2 + ntc) * 64 + lane) * 16; pu0 = *(const u32x4*)up_; pu1 = *(const u32x4*)(up_ + 8); } \
        if (tid < 64) pgc = GC[((size_t)dir * M + (size_t)ch_ * 64 + tid) * 8 + h]; } while (0)
    D2_LOAD(0);
    u32x4 u0, u1;
#define D2_STAGE_A() do { _Pragma("unroll") for (int r = 0; r < 16; ++r) *(LAS u16*)(STl + (mtS * 32 + crow(r, hi)) * 272 + (ntS * 32 + r32) * 2) = f2bf(accS[r]); \
        *(LAS u32x4*)(Ql + sc * 272 + sg * 32) = pq0; *(LAS u32x4*)(Ql + sc * 272 + sg * 32 + 16) = pq1; \
        *(LAS u32x4*)(Kl + sc * 272 + sg * 32) = pk0; *(LAS u32x4*)(Kl + sc * 272 + sg * 32 + 16) = pk1; \
        *(LAS u32x4*)(Wl + sc * 272 + sg * 32) = pw0; *(LAS u32x4*)(Wl + sc * 272 + sg * 32 + 16) = pw1; } while (0)
#define D2_STAGE_B(KT_, GC_) do { _Pragma("unroll") for (int i = 0; i < 4; ++i) { \
            *(LAS u16*)((KT_) + (sg * 16 + 2 * i) * 144 + sc * 2) = (u16)(pk0[i] & 0xffffu); *(LAS u16*)((KT_) + (sg * 16 + 2 * i + 1) * 144 + sc * 2) = (u16)(pk0[i] >> 16); \
            *(LAS u16*)((KT_) + (sg * 16 + 8 + 2 * i) * 144 + sc * 2) = (u16)(pk1[i] & 0xffffu); *(LAS u16*)((KT_) + (sg * 16 + 9 + 2 * i) * 144 + sc * 2) = (u16)(pk1[i] >> 16); } \
        if (tid < 64) (GC_)[tid] = pgc; u0 = pu0; u1 = pu1; } while (0)
    D2_STAGE_A(); D2_STAGE_B(KTl, gcl);
    __syncthreads();
    for (int n = 0; n < nch; ++n) {
        const int ch = ch0 + (dir ? nch - 1 - n : n);
        LAS char* KTc = KTl + (n & 1) * D2_KT2OFF; LAS char* KTn = KTl + ((n + 1) & 1) * D2_KT2OFF;
        LAS float* gcc = gcl + (n & 1) * 64; LAS float* gcn = gcl + ((n + 1) & 1) * 64;
        if (n + 1 < nch) D2_LOAD(n + 1);
        const float glast = gcc[dir ? 0 : 63];
        f32x16 acco = {};
        if (wid >= 4) {
            f32x16 acc = {}; mm_tile<8>(acc, Ql + mtl * 32 * 272, 272, Kl + ntc * 32 * 272, 272, r32, hi);
            const int s = ntc * 32 + r32; const float gs = gcc[s]; float gcv[16];
#pragma unroll
            for (int r = 0; r < 16; ++r) gcv[r] = gcc[mtl * 32 + crow(r, hi)];
#pragma unroll
            for (int r = 0; r < 16; ++r) { const int c = mtl * 32 + crow(r, hi); const bool valid = dir ? (c <= s) : (c >= s);
                const float val = valid ? acc[r] * __expf(fminf(gcv[r] - gs, 0.f)) : 0.f; *(LAS u16*)(QKl + c * 144 + s * 2) = f2bf(val); }
        } else {
            f32x16 acc = {}; mm_tile<8>(acc, STl + mtl * 32 * 272, 272, Wl + ntc * 32 * 272, 272, r32, hi);
            const int c = ntc * 32 + r32; const float e2 = __expf(glast - gcc[c]);
#pragma unroll
            for (int r = 0; r < 16; ++r) { const unsigned uw = r < 8 ? u0[r >> 1] : u1[(r - 8) >> 1]; const float uv = (r & 1) ? bfhi(uw) : bflo(uw);
                const float vn = uv - acc[r]; const int v = mtl * 32 + crow(r, hi);
                *(LAS u16*)(VNl + v * 144 + c * 2) = f2bf(vn); *(LAS u16*)(VN2l + v * 144 + c * 2) = f2bf(vn * e2); }
            mm_tile<8>(acco, STl + mtl * 32 * 272, 272, Ql + ntc * 32 * 272, 272, r32, hi);
            const float eg = __expf(gcc[c]);
#pragma unroll
            for (int r = 0; r < 16; ++r) acco[r] *= eg;
        }
        __syncthreads();
        if (wid < 4) {
            f32x16 acc = acco; const int c = ntc * 32 + r32;
            mm_tile<4>(acc, VNl + mtl * 32 * 144, 144, QKl + ntc * 32 * 144, 144, r32, hi);
            u16* dst = OX + ((size_t)ch * 64 + c) * 1024 + h * 128 + vh * 64 + mtl * 32 + 4 * hi;
#pragma unroll
            for (int q = 0; q < 4; ++q) { u32x2 w; w.x = cvtpk(acc[4 * q], acc[4 * q + 1]); w.y = cvtpk(acc[4 * q + 2], acc[4 * q + 3]); *(u32x2*)(dst + 8 * q) = w; }
        }
        {
            const float gl = __expf(glast);
#pragma unroll
            for (int r = 0; r < 16; ++r) accS[r] *= gl;
            mm_tile<4>(accS, VN2l + mtS * 32 * 144, 144, KTc + ntS * 32 * 144, 144, r32, hi);
        }
        if (n + 1 < nch) { D2_STAGE_A(); D2_STAGE_B(KTn, gcn); }
        __syncthreads();
    }
#undef D2_STAGE_A
#undef D2_STAGE_B
#undef D2_LOAD
    if (!samp) { float* dst = P.out + (dir ? OUT_SB : OUT_SF) + ((size_t)(seq * 8 + h) * 128 + ntS * 32 + r32) * 128 + vh * 64 + mtS * 32 + 4 * hi;
#pragma unroll
        for (int q = 0; q < 4; ++q) { f32x4 t; t[0] = accS[4 * q]; t[1] = accS[4 * q + 1]; t[2] = accS[4 * q + 2]; t[3] = accS[4 * q + 3]; *(f32x4*)(dst + 8 * q) = t; } }
}
__device__ __forceinline__ void d3_phase(const Params& P, int wv) {
    const int lane = ltid(wv) & 63, gw = blockIdx.x * 8 + (ltid(wv) >> 6), NGW = gridDim.x * 8;
    const u16* OF = (const u16*)(P.ws + WS_OF); const u16* OB = (const u16*)(P.ws + WS_OB); const u16* Z = (const u16*)(P.ws + WS_Z); u16* O2 = (u16*)(P.ws + WS_O2);
    const float* og = P.in[24] + (lane & 7) * 16;
    for (int row = gw; row < M; row += NGW) {
        const size_t off = (size_t)row * 1024 + lane * 16;
        const u32x4 a0 = *(const u32x4*)(OF + off), a1 = *(const u32x4*)(OF + off + 8), b0 = *(const u32x4*)(OB + off), b1 = *(const u32x4*)(OB + off + 8);
        const u32x4 z0 = *(const u32x4*)(Z + off), z1 = *(const u32x4*)(Z + off + 8);
        float v[16]; float s = 0.f;
#pragma unroll
        for (int i = 0; i < 4; ++i) { v[2 * i] = bflo(a0[i]) + bflo(b0[i]); v[2 * i + 1] = bfhi(a0[i]) + bfhi(b0[i]); v[8 + 2 * i] = bflo(a1[i]) + bflo(b1[i]); v[9 + 2 * i] = bfhi(a1[i]) + bfhi(b1[i]); }
#pragma unroll
        for (int i = 0; i < 16; ++i) s += v[i] * v[i];
        s += __shfl_xor(s, 1); s += __shfl_xor(s, 2); s += __shfl_xor(s, 4);
        const float rinv = 1.0f / sqrtf(s * (1.0f / 128.0f) + 1e-6f);
        u32x4 w0, w1;
#pragma unroll
        for (int i = 0; i < 4; ++i) {
            const float y0 = v[2 * i] * rinv * og[2 * i] * silu(bflo(z0[i])), y1 = v[2 * i + 1] * rinv * og[2 * i + 1] * silu(bfhi(z0[i]));
            const float y2 = v[8 + 2 * i] * rinv * og[8 + 2 * i] * silu(bflo(z1[i])), y3 = v[9 + 2 * i] * rinv * og[9 + 2 * i] * silu(bfhi(z1[i]));
            w0[i] = cvtpk(y0, y1); w1[i] = cvtpk(y2, y3); }
        *(u32x4*)(O2 + off) = w0; *(u32x4*)(O2 + off + 8) = w1;
    }
}

#define XB_TMO      128
#define XB_XCNT(j)  (256  + 64 * (j))
#define XB_XSUB(j)  (1280 + 64 * (j))
#define XB_XGEN(j)  (2304 + 64 * (j))
#define XB_TOP      3328
#define XB_TOPGEN   3392
#define XCD_BAR_WORDS 3456
#define XB_SPIN_CAP (1u << 18)

__device__ __forceinline__ unsigned xb_ld(unsigned* p)              { return __hip_atomic_load(p, __ATOMIC_RELAXED, __HIP_MEMORY_SCOPE_AGENT); }
__device__ __forceinline__ unsigned xb_add(unsigned* p, unsigned v) { return __hip_atomic_fetch_add(p, v, __ATOMIC_RELAXED, __HIP_MEMORY_SCOPE_AGENT); }
__device__ __forceinline__ unsigned xb_xcc_id() { return (unsigned)__builtin_amdgcn_s_getreg((3 << 11) | 20) & 0xFu; }
#define XB_SPIN(cond, bar) do { unsigned _sp = 0; while (cond) { __builtin_amdgcn_s_sleep(1); \
    if ((++_sp & 255u) == 0u) { if (xb_ld(&(bar)[XB_TMO])) break; if (_sp > XB_SPIN_CAP) { atomicAdd(&(bar)[XB_TMO], 1u); break; } } } } while (0)

struct XcdBarrier {
    unsigned* bar; unsigned x;
    volatile LAS unsigned* st;
};

__device__ __forceinline__ XcdBarrier xcd_barrier_post(unsigned* bar, volatile LAS unsigned* st) {
    XcdBarrier b; b.bar = bar; b.x = xb_xcc_id(); b.st = st;
    if (threadIdx.x == 0) (void)xb_add(&bar[XB_XCNT(b.x)], 1u);
    return b;
}
__device__ __forceinline__ void xcd_barrier_complete(unsigned* bar, unsigned x, unsigned& nloc, unsigned& nx) {
    const unsigned G = gridDim.x * gridDim.y * gridDim.z;
    unsigned sum, cnt, mine, sp = 0u;
    for (;;) {
        sum = 0u; cnt = 0u; mine = 0u;
#pragma unroll
        for (unsigned j = 0; j < 16; ++j) { const unsigned c = xb_ld(&bar[XB_XCNT(j)]); sum += c; cnt += (c > 0u) ? 1u : 0u; mine = (j == x) ? c : mine; }
        if (sum == G) break;
        __builtin_amdgcn_s_sleep(1);
        if ((++sp & 255u) == 0u) { if (xb_ld(&bar[XB_TMO])) break; if (sp > XB_SPIN_CAP) { atomicAdd(&bar[XB_TMO], 1u); break; } }
    }
    nloc = mine > 0u ? mine : 1u; nx = cnt > 0u ? cnt : 1u;
}

__device__ __forceinline__ void xcd_barrier(const XcdBarrier& b) {
    asm volatile("s_waitcnt vmcnt(0)" ::: "memory");
    __syncthreads();
    if (threadIdx.x == 0) {
        unsigned* bar = b.bar;
        __builtin_amdgcn_s_waitcnt(0);
        unsigned nloc = b.st[0], nx = b.st[1];
        if (nloc == 0u) { xcd_barrier_complete(bar, b.x, nloc, nx); b.st[0] = nloc; b.st[1] = nx; }
        const unsigned old = xb_add(&bar[XB_XSUB(b.x)], 1u);
        const unsigned gen = old / nloc;
        if (old + 1u == (gen + 1u) * nloc) {
            __builtin_amdgcn_fence(__ATOMIC_RELEASE, "agent");
            asm volatile("s_waitcnt vmcnt(0)" ::: "memory");
            const unsigned og = xb_add(&bar[XB_TOP], 1u);
            const unsigned tg = og / nx;
            if (og + 1u == (tg + 1u) * nx) xb_add(&bar[XB_TOPGEN], 1u);
            else XB_SPIN(xb_ld(&bar[XB_TOPGEN]) == tg, bar);
            __builtin_amdgcn_fence(__ATOMIC_ACQUIRE, "agent");
            xb_add(&bar[XB_XGEN(b.x)], 1u);
            asm volatile("s_waitcnt vmcnt(0)" ::: "memory");
        } else {
            XB_SPIN(xb_ld(&bar[XB_XGEN(b.x)]) == gen, bar);
            __builtin_amdgcn_fence(__ATOMIC_ACQUIRE, "agent");
            asm volatile("s_waitcnt vmcnt(0)" ::: "memory");
        }
    }
    __syncthreads();
}

__device__ __forceinline__ void xcd_barrier_complete_n(unsigned* bar, unsigned x, unsigned& nloc, unsigned& nx, unsigned NG) {
    unsigned sum, cnt, mine, sp = 0u;
    for (;;) {
        sum = 0u; cnt = 0u; mine = 0u;
#pragma unroll
        for (unsigned j = 0; j < 16; ++j) { const unsigned c = xb_ld(&bar[XB_XCNT(j)]); sum += c; cnt += (c > 0u) ? 1u : 0u; mine = (j == x) ? c : mine; }
        if (sum == NG) break;
        __builtin_amdgcn_s_sleep(1);
        if ((++sp & 255u) == 0u) { if (xb_ld(&bar[XB_TMO])) break; if (sp > XB_SPIN_CAP) { atomicAdd(&bar[XB_TMO], 1u); break; } }
    }
    nloc = mine > 0u ? mine : 1u; nx = cnt > 0u ? cnt : 1u;
}
__device__ __forceinline__ void xcd_barrier_n(const XcdBarrier& b, unsigned NG) {
    asm volatile("s_waitcnt vmcnt(0)" ::: "memory");
    __syncthreads();
    if (threadIdx.x == 0) {
        unsigned* bar = b.bar;
        __builtin_amdgcn_s_waitcnt(0);
        unsigned nloc = b.st[0], nx = b.st[1];
        if (nloc == 0u) { xcd_barrier_complete_n(bar, b.x, nloc, nx, NG); b.st[0] = nloc; b.st[1] = nx; }
        const unsigned old = xb_add(&bar[XB_XSUB(b.x)], 1u);
        const unsigned gen = old / nloc;
        if (old + 1u == (gen + 1u) * nloc) {
            __builtin_amdgcn_fence(__ATOMIC_RELEASE, "agent");
            asm volatile("s_waitcnt vmcnt(0)" ::: "memory");
            const unsigned og = xb_add(&bar[XB_TOP], 1u);
            const unsigned tg = og / nx;
            if (og + 1u == (tg + 1u) * nx) xb_add(&bar[XB_TOPGEN], 1u);
            else XB_SPIN(xb_ld(&bar[XB_TOPGEN]) == tg, bar);
            __builtin_amdgcn_fence(__ATOMIC_ACQUIRE, "agent");
            xb_add(&bar[XB_XGEN(b.x)], 1u);
            asm volatile("s_waitcnt vmcnt(0)" ::: "memory");
        } else {
            XB_SPIN(xb_ld(&bar[XB_XGEN(b.x)]) == gen, bar);
            __builtin_amdgcn_fence(__ATOMIC_ACQUIRE, "agent");
            asm volatile("s_waitcnt vmcnt(0)" ::: "memory");
        }
    }
    __syncthreads();
}

template <class Epi> __device__ __forceinline__ void run_gemm(LAS char* lds, const u16* A, const u16* Bt, int N, int K, const Epi& E, int wv) {
    pg8::Gemm g{A, Bt, M, N, K}; pg8::StaticOrder S; S.init(M, N, (int)gridDim.x, (int)blockIdx.x);
#ifndef SKIP_GEMM
    pg8::gemm_phase<Epi, pg8::StaticOrder, true, true>((PG8_LAS unsigned char*)lds, g, S, E, wv);
#endif
}
template <class Epi> __device__ __forceinline__ void run_gemm_fused(LAS char* lds, const u16* A, const u16* Bt, int N, int K, const Epi& E, int wv) {
    pg8::Gemm g{A, Bt, M, N, K}; pg8::StaticOrder S; S.init(M, N, (int)gridDim.x, (int)blockIdx.x);
    pg8::gemm_phase<Epi, pg8::StaticOrder, false, true>((PG8_LAS unsigned char*)lds, g, S, E, wv);
}
__device__ __forceinline__ void ffn_block(const XcdBarrier& bar, const Params& P, LAS char* lds, const float* modl, int mi, size_t w_in, size_t w_out,
                                          const float* ngain, const float* nmod, int nshift, int nscale, int bank, int wv, int ca0 = 0, int ca1 = 0, int cb0 = 0, int cb1 = 0) {
    unsigned char* ws = P.ws;
    { pg8::EpiSwiglu E{(u16*)(ws + WS_G), FF}; run_gemm(lds, (const u16*)(ws + WS_XN), (const u16*)(ws + w_in), 2 * FF, DM, E, wv); }
    if (ca1 > ca0 && gridDim.x == 256) copy_items(P, lds, ca0, ca1, 32, wv);
    xcd_barrier(bar);
    { pg8::EpiResidNorm E{P.out, modl + (mi + 2) * 1024, ngain, nmod, (u16*)(ws + WS_XN), (float*)(ws + WS_XBUF), (unsigned*)(ws + WS_CTL + 16384 + (size_t)bank * 12288), 0.5f, nshift, nscale, 0};
      run_gemm_fused(lds, (const u16*)(ws + WS_G), (const u16*)(ws + w_out), DM, FF, E, wv); }
    if (cb1 > cb0 && gridDim.x == 256) copy_items(P, lds, cb0, cb1, 192, wv);
    xcd_barrier(bar);
}

__global__ void __launch_bounds__(512, 2) fwd_megakernel(Params P) {
    extern __shared__ __attribute__((aligned(16))) unsigned char lds_raw[];
    LAS char* lds = (LAS char*)lds_raw;
    cg::grid_group grid = cg::this_grid();
    const int wv = __builtin_amdgcn_readfirstlane((int)(threadIdx.x >> 6));
    volatile LAS unsigned* bst = (volatile LAS unsigned*)(lds + LDS_BARST);
    if (threadIdx.x < 2) bst[threadIdx.x] = 0u;
    __syncthreads();
    if (threadIdx.x >= 2 && threadIdx.x < 4) bst[threadIdx.x] = 0u;
    __syncthreads();
    const XcdBarrier bar = xcd_barrier_post((unsigned*)(P.ws + WS_CTL), bst);
    XcdBarrier bar2; bar2.bar = (unsigned*)(P.ws + WS_CTL + 98304); bar2.x = bar.x; bar2.st = bst + 2;
    if (gridDim.x == 256 && blockIdx.x >= 64 && threadIdx.x == 0) (void)xb_add(&bar2.bar[XB_XCNT(bar2.x)], 1u);
    unsigned char* ws = P.ws;
    const float* MOD0 = (const float*)(ws + WS_MOD); const float* MOD1 = MOD0 + 3 * NMOD;
    float* XB = (float*)(ws + WS_XBUF);

    phase0(P, lds, wv);
    grid.sync();
    normmod_phase<true>(P, P.in[10], MOD0, 0, 1, wv);
    xcd_barrier(bar);
    ffn_block(bar, P, lds, MOD0, 0, WS_WIN00, WS_WOUT00, P.in[13], MOD0, 3, 4, 0, wv, 2, 6, 6, 8);
    if (gridDim.x != 256) { copy_items(P, lds, 2, 12, 0, wv); xcd_barrier(bar); }
    { pg8::EpiQKV E{(u16*)(ws + WS_Q), (u16*)(ws + WS_KB), (u16*)(ws + WS_VB), P.out + OUT_NK, P.out + OUT_NV, P.in[15], P.in[16], (const float*)(ws + WS_ROPE), (PG8_LAS float*)(lds + LDS_RED)};
      run_gemm(lds, (const u16*)(ws + WS_XN), (const u16*)(ws + WS_WQKV), 1536, DM, E, wv); }
    if (gridDim.x == 256) copy_items(P, lds, 8, 10, 32, wv);
    cache_copy(P, wv);
    xcd_barrier(bar);
    attn_phase(P, (char*)lds_raw, wv);
    xcd_barrier(bar);
    { pg8::EpiResidNorm E{P.out, MOD0 + 5 * 1024, P.in[26], MOD0, (u16*)(ws + WS_XN), XB, (unsigned*)(ws + WS_CTL + 16384 + 1 * 12288), 1.0f, 6, 7, 0};
      run_gemm_fused(lds, (const u16*)(ws + WS_O), (const u16*)(ws + WS_WO), DM, DM, E, wv); }
    xcd_barrier(bar);
    ffn_block(bar, P, lds, MOD0, 6, WS_WIN01, WS_WOUT01, P.in[10] + DM, MOD1, 0, 1, 2, wv, 10, 12, 0, 0);
    ffn_block(bar, P, lds, MOD1, 0, WS_WIN10, WS_WOUT10, P.in[13] + DM, MOD1, 3, 4, 3, wv);
    { pg8::EpiDN E{(u16*)(ws + WS_QKVR), (u16*)(ws + WS_Z), (float*)(ws + WS_AB)}; run_gemm(lds, (const u16*)(ws + WS_XN), (const u16*)(ws + WS_WDNIN), 4096, DM, E, wv); }
    ab_tile_phase(P, lds, wv);
    xcd_barrier(bar);
    if (gridDim.x == 256) {
        for (int t = blockIdx.x; t < 128 * 8; t += 256) d1_task(P, 64 + (t >> 3), t & 7, lds, wv);
        xcd_barrier(bar);
        if (blockIdx.x < 64) {
            const int b_ = blockIdx.x, t = (((b_ & 7) * 4 + (b_ >> 4)) << 1) | ((b_ >> 3) & 1), rem = t & 31;
            d2_chain(P, 16 + (t >> 5), rem >> 2, (rem >> 1) & 1, rem & 1, lds, wv);
        } else {
            for (int t = blockIdx.x - 64; t < 64 * 8; t += 192) d1_task(P, t >> 3, t & 7, lds, wv);
            xcd_barrier_n(bar2, 192u);
            for (int t = blockIdx.x - 64; t < 512; t += 192) { const int rem = t & 31; d2_chain(P, t >> 5, rem >> 2, (rem >> 1) & 1, rem & 1, lds, wv); __syncthreads(); }
        }
    } else {
        for (int t = blockIdx.x; t < 192 * 8; t += gridDim.x) d1_task(P, t >> 3, t & 7, lds, wv);
        xcd_barrier(bar);
        for (int t = blockIdx.x; t < 576; t += gridDim.x) {
            int seq, rem;
            if (t < 64) { seq = 16 + (t >> 5); rem = t & 31; } else { seq = (t - 64) >> 5; rem = (t - 64) & 31; }
            d2_chain(P, seq, rem >> 2, (rem >> 1) & 1, rem & 1, lds, wv);
            __syncthreads();
        }
    }
    xcd_barrier(bar);
    d3_phase(P, wv);
    xcd_barrier(bar);
    { pg8::EpiResidNorm E{P.out, MOD1 + 5 * 1024, P.in[26] + DM, MOD1, (u16*)(ws + WS_XN), XB, (unsigned*)(ws + WS_CTL + 16384 + 4 * 12288), 1.0f, 6, 7, 0};
      run_gemm_fused(lds, (const u16*)(ws + WS_O2), (const u16*)(ws + WS_WDNO), DM, DM, E, wv); }
    xcd_barrier(bar);
    ffn_block(bar, P, lds, MOD1, 6, WS_WIN11, WS_WOUT11, P.in[29], MOD1, 0, -1, 5, wv);
}

extern "C" void kernel_launch(void* const* d_in, const int* in_sizes, int n_in, void* d_out, int out_size, void* d_ws, size_t ws_size, hipStream_t stream) {
    static int grid = 0;
    if (grid == 0) {
        if (n_in != 30 || out_size != 18874368 || ws_size < WS_END) { fprintf(stderr, "kernel_launch: unexpected shapes n_in %d out %d ws %zu (need %zu)\n", n_in, out_size, ws_size, (size_t)WS_END); grid = -1; return; }
        int dev = 0, cus = 0, per_cu = 0;
        hipGetDevice(&dev); hipDeviceGetAttribute(&cus, hipDeviceAttributeMultiprocessorCount, dev);
        if (hipFuncSetAttribute((const void*)fwd_megakernel, hipFuncAttributeMaxDynamicSharedMemorySize, LDS_BYTES) != hipSuccess) { fprintf(stderr, "kernel_launch: hipFuncSetAttribute failed\n"); grid = -1; return; }
        if (hipOccupancyMaxActiveBlocksPerMultiprocessor(&per_cu, (const void*)fwd_megakernel, 512, LDS_BYTES) != hipSuccess || per_cu < 1) { fprintf(stderr, "kernel_launch: occupancy query failed (%d)\n", per_cu); (void)hipGetLastError(); per_cu = 1; }
        grid = cus * 1;
    }
    if (grid < 0) return;
    if (hipMemsetAsync((char*)d_ws + WS_CTL, 0, CTL_BYTES, stream) != hipSuccess) { fprintf(stderr, "kernel_launch: memset failed\n"); return; }
    Params p{};
    for (int i = 0; i < 30; ++i) p.in[i] = (const float*)d_in[i];
    p.out = (float*)d_out; p.ws = (unsigned char*)d_ws;
    void* args[] = {&p};
    hipError_t e = hipLaunchCooperativeKernel((const void*)fwd_megakernel, dim3(grid), dim3(512), args, LDS_BYTES, stream);
    if (e != hipSuccess) fprintf(stderr, "cooperative launch failed: %s (grid %d)\n", hipGetErrorString(e), grid);
}
```
